# Optimizing an MI355X kernel written in HIP

```python
import math
import jax, jax.numpy as jnp
from jax import lax
import numpy as np

D_MODEL = 2048
BATCH = 8
SEQ = 2048
DEPTH = 2

CHUNK = 64
N_A_LAYERS = DEPTH // 2
N_B_LAYERS = DEPTH - N_A_LAYERS
M_HEADS = 8
M_QK_DIM = D_MODEL // (2 * M_HEADS)
M_V_DIM = D_MODEL // M_HEADS
M_CONV = 4
M_QK_WIDTH = M_HEADS * M_QK_DIM
M_V_WIDTH = M_HEADS * M_V_DIM
M_IN_WIDTH = 2 * M_QK_WIDTH + 2 * M_V_WIDTH + 2 * M_HEADS
A_HEADS = 16
NOPE_DIM = 128
ROPE_DIM = 64
V_DIM = 128
KV_RANK = D_MODEL // 4
Q_RANK = D_MODEL // 4
ROPE_THETA = 10000.0
Q_BLOCK = 128
D_FF = 4 * D_MODEL
DN_ALPHA = (2 * DEPTH) ** 0.25
DN_BETA = (8 * DEPTH) ** -0.25
LN_EPS = 1e-5
RMS_EPS = 1e-6

kernel_name = "yoco_mlstm_mla_deepnorm_trunk"

F32 = jnp.float32


def layer_norm(x, g, b):
    xf = x.astype(F32)
    mu = jnp.mean(xf, axis=-1, keepdims=True)
    var = jnp.mean(jnp.square(xf - mu), axis=-1, keepdims=True)
    return ((xf - mu) * lax.rsqrt(var + LN_EPS) * g.astype(F32) + b.astype(F32)).astype(x.dtype)


def rms_norm(x, g):
    xf = x.astype(F32)
    ms = jnp.mean(jnp.square(xf), axis=-1, keepdims=True)
    return (xf * lax.rsqrt(ms + RMS_EPS) * g.astype(F32)).astype(x.dtype)


def rope(x, cos, sin):
    half = x.shape[-1] // 2
    x1, x2 = x[..., :half], x[..., half:]
    return jnp.concatenate([x1 * cos - x2 * sin, x2 * cos + x1 * sin], axis=-1)


def causal_depthwise_conv(x, w, b):
    c = x.shape[-1]
    y = lax.conv_general_dilated(
        x, w[:, None, :].astype(x.dtype), window_strides=(1,), padding=[(M_CONV - 1, 0)],
        dimension_numbers=("NWC", "WIO", "NWC"), feature_group_count=c)
    return y + b.astype(x.dtype)


def mlstm_mixer(x, w_in, b_gates, conv_w, conv_b, norm_w, w_out):
    B, S, _ = x.shape
    NC = S // CHUNK
    proj = x @ w_in
    qk = proj[..., :2 * M_QK_WIDTH]
    v = proj[..., 2 * M_QK_WIDTH:2 * M_QK_WIDTH + M_V_WIDTH]
    o = proj[..., 2 * M_QK_WIDTH + M_V_WIDTH:2 * M_QK_WIDTH + 2 * M_V_WIDTH]
    gates = proj[..., 2 * M_QK_WIDTH + 2 * M_V_WIDTH:].astype(F32) + b_gates.astype(F32)
    qk = jax.nn.silu(causal_depthwise_conv(qk, conv_w, conv_b))
    q = qk[..., :M_QK_WIDTH] * (M_QK_DIM ** -0.5)
    k = qk[..., M_QK_WIDTH:]
    i_pre = gates[..., :M_HEADS]
    log_f = jax.nn.log_sigmoid(gates[..., M_HEADS:])

    def to_chunks(t, d):
        return t.astype(F32).reshape(B, NC, CHUNK, M_HEADS, d).transpose(1, 0, 3, 2, 4)

    def gate_chunks(t):
        return t.reshape(B, NC, CHUNK, M_HEADS).transpose(1, 0, 3, 2)

    causal = jnp.tril(jnp.ones((CHUNK, CHUNK), dtype=bool))

    def step(carry, inp):
        C, n, m = carry
        qc, kc, vc, ic, fc = inp
        bcum = jnp.cumsum(fc, axis=-1)
        g = bcum[..., -1]
        dmat = bcum[..., :, None] - bcum[..., None, :] + ic[..., None, :]
        dmat = jnp.where(causal, dmat, -jnp.inf)
        inter = bcum + m[..., None]
        m_t = jnp.maximum(jnp.max(dmat, axis=-1), inter)
        w_intra = jnp.exp(dmat - m_t[..., None])
        w_inter = jnp.exp(inter - m_t)
        sw = jnp.einsum('bhtd,bhsd->bhts', qc, kc) * w_intra
        num = jnp.einsum('bhts,bhsv->bhtv', sw, vc) \
            + w_inter[..., None] * jnp.einsum('bhtd,bhdv->bhtv', qc, C)
        den = jnp.sum(sw, axis=-1) + w_inter * jnp.einsum('bhtd,bhd->bht', qc, n)
        h = num / jnp.maximum(jnp.abs(den), jnp.exp(-m_t))[..., None]
        a = g[..., None] - bcum + ic
        m_new = jnp.maximum(g + m, jnp.max(a, axis=-1))
        decay = jnp.exp(g + m - m_new)
        wk = jnp.exp(a - m_new[..., None])
        C_new = decay[..., None, None] * C + jnp.einsum('bhs,bhsd,bhsv->bhdv', wk, kc, vc)
        n_new = decay[..., None] * n + jnp.einsum('bhs,bhsd->bhd', wk, kc)
        return (C_new, n_new, m_new), h

    init = (jnp.zeros((B, M_HEADS, M_QK_DIM, M_V_DIM), F32),
            jnp.zeros((B, M_HEADS, M_QK_DIM), F32),
            jnp.zeros((B, M_HEADS), F32))
    xs = (to_chunks(q, M_QK_DIM), to_chunks(k, M_QK_DIM), to_chunks(v, M_V_DIM),
          gate_chunks(i_pre), gate_chunks(log_f))
    _, h = lax.scan(step, init, xs)
    h = h.transpose(1, 0, 3, 2, 4).reshape(B, S, M_HEADS, M_V_DIM)
    mu = jnp.mean(h, axis=-1, keepdims=True)
    var = jnp.mean(jnp.square(h - mu), axis=-1, keepdims=True)
    hn = (h - mu) * lax.rsqrt(var + LN_EPS) * norm_w.astype(F32).reshape(M_HEADS, M_V_DIM)
    hn = hn.reshape(B, S, M_V_WIDTH).astype(x.dtype)
    return (jax.nn.sigmoid(o) * hn) @ w_out


def shared_latent_kv(x, w_down, norm_w, w_up, cos, sin):
    B, S, _ = x.shape
    ckv = x @ w_down
    c = rms_norm(ckv[..., :KV_RANK], norm_w)
    k_rope = rope(ckv[..., KV_RANK:], cos, sin)
    kv = (c @ w_up).reshape(B, S, A_HEADS, NOPE_DIM + V_DIM)
    return kv[..., :NOPE_DIM], k_rope, kv[..., NOPE_DIM:]


def mla_mixer(x, k_nope, k_rope, v, w_dq, q_norm_w, w_uq, w_out, cos, sin):
    B, S, _ = x.shape
    q = (rms_norm(x @ w_dq, q_norm_w) @ w_uq).reshape(B, S, A_HEADS, NOPE_DIM + ROPE_DIM)
    q_nope = q[..., :NOPE_DIM]
    q_rope = rope(q[..., NOPE_DIM:], cos[:, None, :], sin[:, None, :])
    scale = (NOPE_DIM + ROPE_DIM) ** -0.5
    chunk_id = jnp.arange(S) // CHUNK
    outs = []
    for blk in range(S // Q_BLOCK):
        qs, qe = blk * Q_BLOCK, (blk + 1) * Q_BLOCK
        s = (jnp.einsum('bqhd,bkhd->bhqk', q_nope[:, qs:qe], k_nope[:, :qe])
             + jnp.einsum('bqhr,bkr->bhqk', q_rope[:, qs:qe], k_rope[:, :qe])).astype(F32) * scale
        mask = chunk_id[qs:qe, None] >= chunk_id[None, :qe]
        p = jax.nn.softmax(jnp.where(mask, s, -jnp.inf), axis=-1).astype(v.dtype)
        outs.append(jnp.einsum('bhqk,bkhv->bqhv', p, v[:, :qe]))
    o = jnp.concatenate(outs, axis=1).reshape(B, S, A_HEADS * V_DIM)
    return o @ w_out


def squared_relu_mlp(x, w1, w2):
    return jnp.square(jax.nn.relu(x @ w1)) @ w2


def setup_inputs(seed: int = 0) -> dict:
    key = jax.random.key(seed)
    ks = jax.random.split(key, 21)

    def nrm(k, shape, scale):
        return jax.random.normal(k, shape, F32) * scale

    x = nrm(ks[0], (BATCH, SEQ, D_MODEL), 1.0)
    a_w_in = nrm(ks[1], (N_A_LAYERS, D_MODEL, M_IN_WIDTH), D_MODEL ** -0.5)
    a_b_gates = jnp.concatenate([nrm(ks[2], (N_A_LAYERS, M_HEADS), 0.1),
                                 3.0 + nrm(ks[3], (N_A_LAYERS, M_HEADS), 0.5)], axis=-1)
    a_conv_w = nrm(ks[4], (N_A_LAYERS, M_CONV, 2 * M_QK_WIDTH), M_CONV ** -0.5)
    a_conv_b = nrm(ks[5], (N_A_LAYERS, 2 * M_QK_WIDTH), 0.02)
    a_norm_w = 1.0 + nrm(ks[6], (N_A_LAYERS, M_V_WIDTH), 0.02)
    a_w_out = nrm(ks[7], (N_A_LAYERS, M_V_WIDTH, D_MODEL), DN_BETA * M_V_WIDTH ** -0.5)
    kv_w_down = nrm(ks[8], (D_MODEL, KV_RANK + ROPE_DIM), D_MODEL ** -0.5)
    kv_norm_w = 1.0 + nrm(ks[9], (KV_RANK,), 0.02)
    kv_w_up = nrm(ks[10], (KV_RANK, A_HEADS * (NOPE_DIM + V_DIM)), KV_RANK ** -0.5)
    b_w_dq = nrm(ks[11], (N_B_LAYERS, D_MODEL, Q_RANK), D_MODEL ** -0.5)
    b_q_norm_w = 1.0 + nrm(ks[12], (N_B_LAYERS, Q_RANK), 0.02)
    b_w_uq = nrm(ks[13], (N_B_LAYERS, Q_RANK, A_HEADS * (NOPE_DIM + ROPE_DIM)), Q_RANK ** -0.5)
    b_w_out = nrm(ks[14], (N_B_LAYERS, A_HEADS * V_DIM, D_MODEL), DN_BETA * (A_HEADS * V_DIM) ** -0.5)
    mlp_w1 = nrm(ks[15], (DEPTH, D_MODEL, D_FF), D_MODEL ** -0.5)
    mlp_w2 = nrm(ks[16], (DEPTH, D_FF, D_MODEL), DN_BETA * D_FF ** -0.5)
    ln1_g = 1.0 + nrm(ks[17], (DEPTH, D_MODEL), 0.02)
    ln1_b = nrm(ks[18], (DEPTH, D_MODEL), 0.02)
    ln2_g = 1.0 + nrm(ks[19], (DEPTH, D_MODEL), 0.02)
    ln2_b = nrm(ks[20], (DEPTH, D_MODEL), 0.02)
    return {"x": x, "a_w_in": a_w_in, "a_b_gates": a_b_gates, "a_conv_w": a_conv_w,
            "a_conv_b": a_conv_b, "a_norm_w": a_norm_w, "a_w_out": a_w_out,
            "kv_w_down": kv_w_down, "kv_norm_w": kv_norm_w, "kv_w_up": kv_w_up,
            "b_w_dq": b_w_dq, "b_q_norm_w": b_q_norm_w, "b_w_uq": b_w_uq, "b_w_out": b_w_out,
            "mlp_w1": mlp_w1, "mlp_w2": mlp_w2,
            "ln1_g": ln1_g, "ln1_b": ln1_b, "ln2_g": ln2_g, "ln2_b": ln2_b}


def reference(x, a_w_in, a_b_gates, a_conv_w, a_conv_b, a_norm_w, a_w_out,
              kv_w_down, kv_norm_w, kv_w_up, b_w_dq, b_q_norm_w, b_w_uq, b_w_out,
              mlp_w1, mlp_w2, ln1_g, ln1_b, ln2_g, ln2_b):
    S = x.shape[1]
    pos = jnp.arange(S, dtype=F32)
    inv_freq = ROPE_THETA ** (-jnp.arange(0, ROPE_DIM, 2, dtype=F32) / ROPE_DIM)
    ang = pos[:, None] * inv_freq[None, :]
    cos = jnp.cos(ang).astype(x.dtype)
    sin = jnp.sin(ang).astype(x.dtype)
    k_nope = k_rope = v_shared = None
    for layer in range(DEPTH):
        if layer < N_A_LAYERS:
            mix = mlstm_mixer(x, a_w_in[layer], a_b_gates[layer], a_conv_w[layer],
                              a_conv_b[layer], a_norm_w[layer], a_w_out[layer])
        else:
            if layer == N_A_LAYERS:
                k_nope, k_rope, v_shared = shared_latent_kv(x, kv_w_down, kv_norm_w, kv_w_up, cos, sin)
            j = layer - N_A_LAYERS
            mix = mla_mixer(x, k_nope, k_rope, v_shared, b_w_dq[j], b_q_norm_w[j],
                            b_w_uq[j], b_w_out[j], cos, sin)
        x = layer_norm(DN_ALPHA * x + mix, ln1_g[layer], ln1_b[layer])
        x = layer_norm(DN_ALPHA * x + squared_relu_mlp(x, mlp_w1[layer], mlp_w2[layer]),
                       ln2_g[layer], ln2_b[layer])
    return x
```

```cpp
#include <hip/hip_runtime.h>
#include <hip/hip_cooperative_groups.h>
#include <cstdio>
#include <cstdint>
namespace cg = cooperative_groups;
namespace pg8 {
#define PG8_LAS __attribute__((address_space(3)))
typedef unsigned short bf16_t;
typedef short bf16x8 __attribute__((ext_vector_type(8)));
typedef float f32x4 __attribute__((ext_vector_type(4)));
typedef unsigned u32x4 __attribute__((ext_vector_type(4)));
constexpr int BM = 256, BK = 64, HALF = 128, HTB = HALF * BK * 2  , STAGE_BYTES = 8 * HTB, NXCD = 8, WGM = 8;

__host__ __device__ __forceinline__ int lds_byte(int r, int c) { const int st = (r >> 4) * 2 + (c >> 5), rr = r & 15, cc = c & 31, ob = rr * 64 + cc * 2; return st * 1024 + (ob ^ (((ob >> 9) & 1) << 5)); }
__host__ __device__ __forceinline__ void stage_rc(int b, int& R, int& C) { const int st = b / 1024, sb = b % 1024, swz = sb ^ (((sb >> 9) & 1) << 5); R = (st >> 1) * 16 + swz / 64; C = (st & 1) * 32 + (swz % 64) / 2; }
__host__ __device__ __forceinline__ int perm32(int rho) { const int n = rho >> 4, i = rho & 15; return 8 * (i >> 2) + 4 * n + (i & 3); }

struct Unit { int pm, pn; };
struct Gemm { const bf16_t* A; const bf16_t* Bt; int M, N, K; };

struct StaticOrder {
    int nM, nN, nwg, G, c;
    __host__ __device__ void init(int M, int N, int G_, int c_) { nM = M / BM; nN = N / BM; nwg = nM * nN; G = G_; c = c_; }
    __host__ __device__ bool next(int i, Unit& u) const {
        const long L = (long)i * G + c; if (L >= nwg) return false;
        int wgid = (int)L; { const int q = nwg / NXCD, r = nwg % NXCD, xcd = wgid % NXCD, off = wgid / NXCD; wgid = (xcd < r ? xcd * (q + 1) : r * (q + 1) + (xcd - r) * q) + off; }
        const int nig = WGM * nN, gid = wgid / nig, fm = gid * WGM, gsz = (nM - fm) < WGM ? (nM - fm) : WGM;
        u.pm = fm + ((wgid % nig) % gsz); u.pn = (wgid % nig) / gsz; return true;
    }
    __device__ __forceinline__ void a_ready(const Unit&) const {}
    __device__ __forceinline__ void done(const Unit&) const {}
};

typedef float f32x2c_t __attribute__((ext_vector_type(2))); typedef __bf16 bf16x2c_t __attribute__((ext_vector_type(2)));
__device__ __forceinline__ unsigned cvt_pk_bf16(float lo, float hi) { const f32x2c_t v = {lo, hi}; const bf16x2c_t b = __builtin_convertvector(v, bf16x2c_t); return __builtin_bit_cast(unsigned, b); }
typedef float f32x2 __attribute__((ext_vector_type(2)));
typedef unsigned u32x2 __attribute__((ext_vector_type(2)));
__device__ __forceinline__ float bf_lo(unsigned w) { return __uint_as_float(w << 16); }
__device__ __forceinline__ float bf_hi(unsigned w) { return __uint_as_float(w & 0xffff0000u); }
__device__ __forceinline__ u32x4 pack8(const f32x4 a, const f32x4 b) { u32x4 w; w.x = cvt_pk_bf16(a[0], a[1]); w.y = cvt_pk_bf16(a[2], a[3]); w.z = cvt_pk_bf16(b[0], b[1]); w.w = cvt_pk_bf16(b[2], b[3]); return w; }
#define EPI_LOOP_BEGIN \
    _Pragma("unroll") for (int ai = 0; ai < 2; ++ai) _Pragma("unroll") for (int m = 0; m < 4; ++m) { const int row = u.pm * BM + ai * HALF + wr * 64 + m * 16 + fr; \
    _Pragma("unroll") for (int bj = 0; bj < 2; ++bj) { const int col0 = u.pn * BM + bj * HALF + wc * 32 + 8 * fq; const f32x4 v0 = acc[ai][bj][m][0], v1 = acc[ai][bj][m][1];
#define EPI_LOOP_END } asm volatile("" ::: "memory"); }
template <int ACT> struct EpiSplitBf16 {
    static constexpr bool PERM = true, AFTER_DRAIN = false;
    bf16_t* O; int ldc; int tiles_per; size_t split_stride; int vperm;
    __device__ __forceinline__ void operator()(const f32x4 (&acc)[2][2][4][2], const Unit& u, int wr, int wc, int fr, int fq) const {
        const int t = u.pn / tiles_per; bf16_t* base = O + (size_t)t * split_stride; const int csub = t * tiles_per * BM;
        EPI_LOOP_BEGIN
            f32x4 a = v0, b = v1;
            if (ACT == 1) {
#pragma unroll
                for (int e = 0; e < 4; ++e) { const float x = fmaxf(a[e], 0.f), y = fmaxf(b[e], 0.f); a[e] = x * x; b[e] = y * y; } }
            if (vperm && t == 1) { const int cl_ = col0 - csub;
                *(u32x4*)(base + ((size_t)((row >> 11) * 32 + (cl_ >> 6)) * 2048 + (row & 2047)) * 64 + (cl_ & 63)) = pack8(a, b); }
            else *(u32x4*)(base + (size_t)row * ldc + (col0 - csub)) = pack8(a, b);
        EPI_LOOP_END
    }
};
template <bool RBF16> struct EpiResid {
    static constexpr bool PERM = true, AFTER_DRAIN = false;
    const void* R; float* Y; int ldc; float alpha;
    __device__ __forceinline__ void operator()(const f32x4 (&acc)[2][2][4][2], const Unit& u, int wr, int wc, int fr, int fq) const {
        EPI_LOOP_BEGIN
            const size_t off = (size_t)row * ldc + col0; f32x4 r0, r1;
            if (RBF16) { const u32x4 w = *(const u32x4*)((const bf16_t*)R + off); r0 = (f32x4){bf_lo(w.x), bf_hi(w.x), bf_lo(w.y), bf_hi(w.y)}; r1 = (f32x4){bf_lo(w.z), bf_hi(w.z), bf_lo(w.w), bf_hi(w.w)}; }
            else { r0 = *(const f32x4*)((const float*)R + off); r1 = *(const f32x4*)((const float*)R + off + 4); }
            *(f32x4*)(Y + off) = r0 * alpha + v0; *(f32x4*)(Y + off + 4) = r1 * alpha + v1;
        EPI_LOOP_END
    }
};

__device__ __forceinline__ void ln_row(const float* st, int row, float& mu, float& rstd) {
    const float s = st[2 * (size_t)row], q = st[2 * (size_t)row + 1]; mu = s * (1.0f / 2048.0f);
    const float var = fmaxf(q * (1.0f / 2048.0f) - mu * mu, 0.f); rstd = 1.0f / sqrtf(var + 1e-5f);
}
__device__ __forceinline__ float sum8(const f32x4 a, const f32x4 b) { return ((a[0] + a[1]) + (a[2] + a[3])) + ((b[0] + b[1]) + (b[2] + b[3])); }
__device__ __forceinline__ float ssq8(const f32x4 a, const f32x4 b) { return ((a[0] * a[0] + a[1] * a[1]) + (a[2] * a[2] + a[3] * a[3])) + ((b[0] * b[0] + b[1] * b[1]) + (b[2] * b[2] + b[3] * b[3])); }
#define ROWSTATS_FLUSH(stn) do { _Pragma("unroll") for (int ri = 0; ri < 8; ++ri) { float s_ = rs[ri], q_ = rq[ri]; s_ += __shfl_xor(s_, 16); s_ += __shfl_xor(s_, 32); q_ += __shfl_xor(q_, 16); q_ += __shfl_xor(q_, 32); \
        if (fq == 0) { const int row_ = u.pm * BM + (ri >> 2) * HALF + wr * 64 + (ri & 3) * 16 + fr; __hip_atomic_fetch_add((stn) + 2 * (size_t)row_, s_, __ATOMIC_RELAXED, __HIP_MEMORY_SCOPE_AGENT); __hip_atomic_fetch_add((stn) + 2 * (size_t)row_ + 1, q_, __ATOMIC_RELAXED, __HIP_MEMORY_SCOPE_AGENT); } } } while (0)
struct EpiFirst {
    static constexpr bool PERM = true, AFTER_DRAIN = false;
    const float* X; bf16_t* Y; float* stn; float alpha;
    __device__ __forceinline__ void operator()(const f32x4 (&acc)[2][2][4][2], const Unit& u, int wr, int wc, int fr, int fq) const {
        float rs[8], rq[8];
#pragma unroll
        for (int i = 0; i < 8; ++i) { rs[i] = 0.f; rq[i] = 0.f; }
#pragma unroll
        for (int bj = 0; bj < 2; ++bj) { const int col0 = u.pn * BM + bj * HALF + wc * 32 + 8 * fq;
#pragma unroll
            for (int ai = 0; ai < 2; ++ai)
#pragma unroll
                for (int m = 0; m < 4; ++m) { const int row = u.pm * BM + ai * HALF + wr * 64 + m * 16 + fr; const size_t off = (size_t)row * 2048 + col0;
                    const f32x4 y0 = *(const f32x4*)(X + off) * alpha + acc[ai][bj][m][0], y1 = *(const f32x4*)(X + off + 4) * alpha + acc[ai][bj][m][1];
                    rs[ai * 4 + m] += sum8(y0, y1); rq[ai * 4 + m] += ssq8(y0, y1);
                    *(u32x4*)(Y + off) = pack8(y0, y1); asm volatile("" ::: "memory"); } }
        ROWSTATS_FLUSH(stn);
    }
};
template <bool LAST> struct EpiResLn {
    static constexpr bool PERM = true, AFTER_DRAIN = false;
    bf16_t* XA; const float* stp; const float* g; const float* b; float* stn; float* Yf; float alpha;
    __device__ __forceinline__ void operator()(const f32x4 (&acc)[2][2][4][2], const Unit& u, int wr, int wc, int fr, int fq) const {
        float rs[8], rq[8], mu8[8], rstd8[8];
#pragma unroll
        for (int i = 0; i < 8; ++i) { rs[i] = 0.f; rq[i] = 0.f; ln_row(stp, u.pm * BM + (i >> 2) * HALF + wr * 64 + (i & 3) * 16 + fr, mu8[i], rstd8[i]); }
#pragma unroll
        for (int bj = 0; bj < 2; ++bj) { const int col0 = u.pn * BM + bj * HALF + wc * 32 + 8 * fq;
            const f32x4 g0 = *(const f32x4*)(g + col0), g1 = *(const f32x4*)(g + col0 + 4), b0 = *(const f32x4*)(b + col0), b1 = *(const f32x4*)(b + col0 + 4);
#pragma unroll
            for (int ai = 0; ai < 2; ++ai)
#pragma unroll
                for (int m = 0; m < 4; ++m) { const int ri = ai * 4 + m; const int row = u.pm * BM + ai * HALF + wr * 64 + m * 16 + fr; const size_t off = (size_t)row * 2048 + col0;
                    const u32x4 w = *(const u32x4*)(XA + off);
                    const f32x4 p0 = {bf_lo(w.x), bf_hi(w.x), bf_lo(w.y), bf_hi(w.y)}, p1 = {bf_lo(w.z), bf_hi(w.z), bf_lo(w.w), bf_hi(w.w)};
                    const f32x4 y0 = ((p0 - mu8[ri]) * rstd8[ri] * g0 + b0) * alpha + acc[ai][bj][m][0], y1 = ((p1 - mu8[ri]) * rstd8[ri] * g1 + b1) * alpha + acc[ai][bj][m][1];
                    if (LAST) { *(f32x4*)(Yf + off) = y0; *(f32x4*)(Yf + off + 4) = y1; }
                    else { rs[ri] += sum8(y0, y1); rq[ri] += ssq8(y0, y1); *(u32x4*)(XA + off) = pack8(y0, y1); }
                    asm volatile("" ::: "memory"); } }
        if (!LAST) ROWSTATS_FLUSH(stn);
    }
};
struct EpiUpLn {
    static constexpr bool PERM = true, AFTER_DRAIN = false;
    bf16_t* O; int ldc; const float* st; const float* uv; const float* cv;
    __device__ __forceinline__ void operator()(const f32x4 (&acc)[2][2][4][2], const Unit& u, int wr, int wc, int fr, int fq) const {
        float mu8[8], rstd8[8];
#pragma unroll
        for (int i = 0; i < 8; ++i) ln_row(st, u.pm * BM + (i >> 2) * HALF + wr * 64 + (i & 3) * 16 + fr, mu8[i], rstd8[i]);
#pragma unroll
        for (int bj = 0; bj < 2; ++bj) { const int col0 = u.pn * BM + bj * HALF + wc * 32 + 8 * fq;
            const f32x4 u0 = *(const f32x4*)(uv + col0), u1 = *(const f32x4*)(uv + col0 + 4), c0 = *(const f32x4*)(cv + col0), c1 = *(const f32x4*)(cv + col0 + 4);
#pragma unroll
            for (int ai = 0; ai < 2; ++ai)
#pragma unroll
                for (int m = 0; m < 4; ++m) { const int ri = ai * 4 + m; const int row = u.pm * BM + ai * HALF + wr * 64 + m * 16 + fr;
                    f32x4 a = (acc[ai][bj][m][0] - u0 * mu8[ri]) * rstd8[ri] + c0, bb = (acc[ai][bj][m][1] - u1 * mu8[ri]) * rstd8[ri] + c1;
#pragma unroll
                    for (int e = 0; e < 4; ++e) { const float x = fmaxf(a[e], 0.f), y = fmaxf(bb[e], 0.f); a[e] = x * x; bb[e] = y * y; }
                    *(u32x4*)(O + (size_t)row * ldc + col0) = pack8(a, bb); asm volatile("" ::: "memory"); } }
    }
};
struct EpiDown {
    static constexpr bool PERM = true, AFTER_DRAIN = false;
    bf16_t* C; bf16_t* QL; bf16_t* KR; float* stats; const float* rope;
    const float* st; const float* uv; const float* cv;
    __device__ __forceinline__ void operator()(const f32x4 (&acc)[2][2][4][2], const Unit& u, int wr, int wc, int fr, int fq) const {
        if (u.pn < 4) {
            bf16_t* base = (u.pn < 2) ? C : QL; const int csub = (u.pn < 2) ? 0 : 512;
#pragma unroll
            for (int ai = 0; ai < 2; ++ai)
#pragma unroll
                for (int m = 0; m < 4; ++m) { const int row = u.pm * BM + ai * HALF + wr * 64 + m * 16 + fr; float ss = 0.f; float mu, rstd; ln_row(st, row, mu, rstd);
#pragma unroll
                    for (int bj = 0; bj < 2; ++bj) { const int col0 = u.pn * BM + bj * HALF + wc * 32 + 8 * fq;
                        const f32x4 v0 = (acc[ai][bj][m][0] - *(const f32x4*)(uv + col0) * mu) * rstd + *(const f32x4*)(cv + col0), v1 = (acc[ai][bj][m][1] - *(const f32x4*)(uv + col0 + 4) * mu) * rstd + *(const f32x4*)(cv + col0 + 4);
                        ss += (v0[0] * v0[0] + v0[1] * v0[1]) + (v0[2] * v0[2] + v0[3] * v0[3]) + (v1[0] * v1[0] + v1[1] * v1[1]) + (v1[2] * v1[2] + v1[3] * v1[3]);
                        *(u32x4*)(base + (size_t)row * 512 + (col0 - csub)) = pack8(v0, v1); }
                    ss += __shfl_xor(ss, 16); ss += __shfl_xor(ss, 32);
                    if (fq == 0) __hip_atomic_fetch_add(stats + (size_t)row * 2 + (u.pn >> 1), ss, __ATOMIC_RELAXED, __HIP_MEMORY_SCOPE_AGENT);
                    asm volatile("" ::: "memory"); }
        } else {
#pragma unroll
            for (int ai = 0; ai < 2; ++ai)
#pragma unroll
                for (int m = 0; m < 4; ++m) { const int row = u.pm * BM + ai * HALF + wr * 64 + m * 16 + fr; const int pos = row & 2047;
                    const int c = wc * 32 + 8 * fq;
                    if (c < 64) { float mu, rstd; ln_row(st, row, mu, rstd); const f32x4 v0 = (acc[ai][0][m][0] - *(const f32x4*)(uv + 1024 + c) * mu) * rstd + *(const f32x4*)(cv + 1024 + c), v1 = (acc[ai][0][m][1] - *(const f32x4*)(uv + 1024 + c + 4) * mu) * rstd + *(const f32x4*)(cv + 1024 + c + 4); const f32x4 cs0 = *(const f32x4*)(rope + ((size_t)pos * 32 + (c >> 1)) * 2), cs1 = *(const f32x4*)(rope + ((size_t)pos * 32 + (c >> 1) + 2) * 2);
                        f32x4 o0, o1;
                        o0[0] = v0[0] * cs0[0] - v0[1] * cs0[1]; o0[1] = v0[1] * cs0[0] + v0[0] * cs0[1]; o0[2] = v0[2] * cs0[2] - v0[3] * cs0[3]; o0[3] = v0[3] * cs0[2] + v0[2] * cs0[3];
                        o1[0] = v1[0] * cs1[0] - v1[1] * cs1[1]; o1[1] = v1[1] * cs1[0] + v1[0] * cs1[1]; o1[2] = v1[2] * cs1[2] - v1[3] * cs1[3]; o1[3] = v1[3] * cs1[2] + v1[2] * cs1[3];
                        *(u32x4*)(KR + (size_t)row * 64 + c) = pack8(o0, o1); } asm volatile("" ::: "memory"); }
        }
    }
};
struct EpiKvUp {
    static constexpr bool PERM = true, AFTER_DRAIN = false;
    bf16_t* KN; bf16_t* VV; const float* stats;
    __device__ __forceinline__ void operator()(const f32x4 (&acc)[2][2][4][2], const Unit& u, int wr, int wc, int fr, int fq) const {
#pragma unroll
        for (int ai = 0; ai < 2; ++ai)
#pragma unroll
            for (int m = 0; m < 4; ++m) { const int row = u.pm * BM + ai * HALF + wr * 64 + m * 16 + fr;
                const float rstd = 1.0f / sqrtf(stats[(size_t)row * 2] * (1.0f / 512.0f) + 1e-6f);
#pragma unroll
                for (int bj = 0; bj < 2; ++bj) { bf16_t* base = bj ? VV : KN; const int c = wc * 32 + 8 * fq;
                    *(u32x4*)(base + ((size_t)((row >> 11) * 16 + u.pn) * 2048 + (row & 2047)) * 128 + c) = pack8(acc[ai][bj][m][0] * rstd, acc[ai][bj][m][1] * rstd); } asm volatile("" ::: "memory"); }
    }
};
struct EpiQUp {
    static constexpr bool PERM = true, AFTER_DRAIN = false;
    bf16_t* Q; const float* stats; const float* rope; float qscale;
    __device__ __forceinline__ void operator()(const f32x4 (&acc)[2][2][4][2], const Unit& u, int wr, int wc, int fr, int fq) const {
#pragma unroll
        for (int ai = 0; ai < 2; ++ai)
#pragma unroll
            for (int m = 0; m < 4; ++m) { const int row = u.pm * BM + ai * HALF + wr * 64 + m * 16 + fr; const int pos = row & 2047;
                const float rs = qscale / sqrtf(stats[(size_t)row * 2 + 1] * (1.0f / 512.0f) + 1e-6f);
#pragma unroll
                for (int bj = 0; bj < 2; ++bj) { const int col0 = u.pn * BM + bj * HALF + wc * 32 + 8 * fq; const int j = col0 % 192;
                    f32x4 v0 = acc[ai][bj][m][0] * rs, v1 = acc[ai][bj][m][1] * rs;
                    if (j >= 128) { const int i0 = (j - 128) >> 1; const f32x4 cs0 = *(const f32x4*)(rope + ((size_t)pos * 32 + i0) * 2), cs1 = *(const f32x4*)(rope + ((size_t)pos * 32 + i0 + 2) * 2);
                        f32x4 o0, o1;
                        o0[0] = v0[0] * cs0[0] - v0[1] * cs0[1]; o0[1] = v0[1] * cs0[0] + v0[0] * cs0[1]; o0[2] = v0[2] * cs0[2] - v0[3] * cs0[3]; o0[3] = v0[3] * cs0[2] + v0[2] * cs0[3];
                        o1[0] = v1[0] * cs1[0] - v1[1] * cs1[1]; o1[1] = v1[1] * cs1[0] + v1[0] * cs1[1]; o1[2] = v1[2] * cs1[2] - v1[3] * cs1[3]; o1[3] = v1[3] * cs1[2] + v1[2] * cs1[3];
                        v0 = o0; v1 = o1; }
                    *(u32x4*)(Q + (size_t)row * 3072 + col0) = pack8(v0, v1); } asm volatile("" ::: "memory"); }
    }
};
template <class Epi, class Sched, bool ALIGN_EPI = false, bool SP2 = false>
__device__ __forceinline__ void gemm_phase(PG8_LAS unsigned char* lds, const Gemm g, const Sched& S, const Epi& E) {
    int tid_ = threadIdx.x; asm volatile("" : "+v"(tid_));
    const int tid = tid_, wid = __builtin_amdgcn_readfirstlane(tid >> 6), lane = tid & 63, wr = wid >> 2, wc = wid & 3, fr = lane & 15, fq = lane >> 4;
    const int K = g.K, nt = K / BK;
    unsigned voffA[2], voffB[2];
#pragma unroll
    for (int i = 0; i < 2; ++i) { int R, C; stage_rc(tid * 16 + i * 8192, R, C); const int Rb = Epi::PERM ? ((R & ~31) + perm32(R & 31)) : R;
        voffA[i] = (unsigned)(R * K + C) * 2u; voffB[i] = (unsigned)(Rb * K + C) * 2u; }
    const size_t kstep = (size_t)(BK * 2);
    const size_t hstep = (size_t)HALF * K * 2;
    const size_t tstep = 2 * hstep;
    const unsigned ldsw = (unsigned)wid * 1024u;
    const int aoff = lds_byte(wr * 64 + fr, fq * 8), boff = lds_byte(wc * 32 + fr, fq * 8);
#define PG8_SA(b, h) (((b) * 2 + (h)) * HTB)
#define PG8_SB(b, h) ((4 + (b) * 2 + (h)) * HTB)
#define PG8_STAGE(bufoff, gbase, voff) do { _Pragma("unroll") for (int _i = 0; _i < 2; ++_i) \
        __builtin_amdgcn_global_load_lds((const unsigned*)((const char*)(gbase) + (voff)[_i]), (PG8_LAS unsigned*)(lds + (bufoff) + ldsw + _i * 8192), 16, 0, 0); } while (0)
#define PG8_LDA(dst, b, h) do { _Pragma("unroll") for (int m = 0; m < 4; ++m) _Pragma("unroll") for (int k = 0; k < 2; ++k) dst[m][k] = *(const PG8_LAS bf16x8*)(lds + PG8_SA(b, h) + aoff + m * 2048 + k * 1024); } while (0)
#define PG8_LDB(dst, b, h) do { _Pragma("unroll") for (int n = 0; n < 2; ++n) _Pragma("unroll") for (int k = 0; k < 2; ++k) dst[n][k] = *(const PG8_LAS bf16x8*)(lds + PG8_SB(b, h) + boff + n * 2048 + k * 1024); } while (0)
#define PG8_MMA(ai, bj, At, Bt) do { __builtin_amdgcn_s_setprio(1); _Pragma("unroll") for (int m = 0; m < 4; ++m) _Pragma("unroll") for (int n = 0; n < 2; ++n) _Pragma("unroll") for (int k = 0; k < 2; ++k) \
        acc[ai][bj][m][n] = __builtin_amdgcn_mfma_f32_16x16x32_bf16(Bt[n][k], At[m][k], acc[ai][bj][m][n], 0, 0, 0); __builtin_amdgcn_s_setprio(0); } while (0)
#define PG8_WAIT_V(n) asm volatile("s_waitcnt vmcnt(" #n ")" ::: "memory")
#define PG8_WAIT_L(n) asm volatile("s_waitcnt lgkmcnt(" #n ")" ::: "memory")
#define PG8_BAR __builtin_amdgcn_s_barrier()
#define PG8_SCHED __builtin_amdgcn_sched_barrier(0)
    Unit cur, nxt; int ui = 0;
    if (!S.next(0, cur)) return;
    f32x4 acc[2][2][4][2];
#pragma unroll
    for (int a = 0; a < 2; ++a)
#pragma unroll
        for (int b = 0; b < 2; ++b)
#pragma unroll
            for (int m = 0; m < 4; ++m)
#pragma unroll
                for (int n = 0; n < 2; ++n) acc[a][b][m][n] = (f32x4){0.f, 0.f, 0.f, 0.f};
    bf16x8 At[4][2], B0[2][2], B1[2][2];
    const char* cA = (const char*)g.A + (size_t)cur.pm * tstep; const char* cB = (const char*)g.Bt + (size_t)cur.pn * tstep;
    S.a_ready(cur);
    if constexpr (SP2) {
        PG8_STAGE(PG8_SB(0, 0), cB, voffB); PG8_STAGE(PG8_SB(0, 1), cB + hstep, voffB); PG8_STAGE(PG8_SA(0, 0), cA, voffA); PG8_STAGE(PG8_SA(0, 1), cA + hstep, voffA);
        if (wr == 1) PG8_BAR;
        PG8_WAIT_V(2); PG8_BAR;
        PG8_STAGE(PG8_SB(1, 0), cB + kstep, voffB); PG8_STAGE(PG8_SA(1, 0), cA + kstep, voffA); PG8_STAGE(PG8_SB(1, 1), cB + hstep + kstep, voffB);
        PG8_WAIT_V(6); PG8_BAR;
    } else {
        PG8_STAGE(PG8_SB(0, 0), cB, voffB); PG8_STAGE(PG8_SA(0, 0), cA, voffA); PG8_STAGE(PG8_SB(0, 1), cB + hstep, voffB); PG8_STAGE(PG8_SA(0, 1), cA + hstep, voffA);
        if (wr == 1) PG8_BAR;
        PG8_WAIT_V(4); PG8_BAR;
        PG8_STAGE(PG8_SB(1, 0), cB + kstep, voffB); PG8_STAGE(PG8_SA(1, 0), cA + kstep, voffA); PG8_STAGE(PG8_SB(1, 1), cB + hstep + kstep, voffB);
        PG8_WAIT_V(6); PG8_BAR;
    }
    for (;;) {
        const bool has_next = S.next(ui + 1, nxt);
        const char* nA = has_next ? (const char*)g.A + (size_t)nxt.pm * tstep : cA; const char* nB = has_next ? (const char*)g.Bt + (size_t)nxt.pn * tstep : cB;
        for (int t = 0; t < nt; t += 2) {
            const bool last = (t == nt - 2);
            const char* a1 = cA + (size_t)(t + 1) * kstep;
            const char* a2 = last ? nA : cA + (size_t)(t + 2) * kstep; const char* b2 = last ? nB : cB + (size_t)(t + 2) * kstep;
            const char* a3 = a2 + kstep; const char* b3 = b2 + kstep;
            if (last && has_next) S.a_ready(nxt);
            if constexpr (SP2) {
            PG8_LDB(B0, 0, 0); PG8_LDB(B1, 0, 1); PG8_SCHED; PG8_LDA(At, 0, 0); PG8_STAGE(PG8_SA(1, 1), a1 + hstep, voffA);
            PG8_WAIT_V(8); PG8_WAIT_L(0); PG8_BAR; PG8_MMA(0, 0, At, B0); PG8_MMA(0, 1, At, B1); PG8_BAR; PG8_SCHED;
            PG8_LDA(At, 0, 1); PG8_STAGE(PG8_SB(0, 0), b2, voffB); PG8_STAGE(PG8_SB(0, 1), b2 + hstep, voffB); PG8_STAGE(PG8_SA(0, 0), a2, voffA);
            PG8_WAIT_V(8); PG8_WAIT_L(0); PG8_BAR; PG8_MMA(1, 0, At, B0); PG8_MMA(1, 1, At, B1); PG8_BAR; PG8_SCHED;
            PG8_LDB(B0, 1, 0); PG8_LDB(B1, 1, 1); PG8_SCHED; PG8_LDA(At, 1, 0); PG8_STAGE(PG8_SA(0, 1), a2 + hstep, voffA);
            PG8_WAIT_V(8); PG8_WAIT_L(0); PG8_BAR; PG8_MMA(0, 0, At, B0); PG8_MMA(0, 1, At, B1); PG8_BAR; PG8_SCHED;
            PG8_LDA(At, 1, 1); PG8_STAGE(PG8_SB(1, 0), b3, voffB); PG8_STAGE(PG8_SB(1, 1), b3 + hstep, voffB); PG8_STAGE(PG8_SA(1, 0), a3, voffA);
            PG8_WAIT_V(8); PG8_WAIT_L(0); PG8_BAR; PG8_MMA(1, 0, At, B0); PG8_MMA(1, 1, At, B1); PG8_BAR; PG8_SCHED;
            } else {
            PG8_LDB(B0, 0, 0); PG8_SCHED; PG8_LDA(At, 0, 0); PG8_STAGE(PG8_SA(1, 1), a1 + hstep, voffA);
            PG8_WAIT_L(8); PG8_BAR; PG8_WAIT_L(0); PG8_MMA(0, 0, At, B0); PG8_BAR; PG8_SCHED;
            PG8_LDB(B1, 0, 1); PG8_STAGE(PG8_SB(0, 0), b2, voffB);
            PG8_BAR; PG8_WAIT_L(0); PG8_MMA(0, 1, At, B1); PG8_BAR;
            PG8_LDA(At, 0, 1); PG8_STAGE(PG8_SA(0, 0), a2, voffA);
            PG8_BAR; PG8_WAIT_L(0); PG8_MMA(1, 0, At, B0); PG8_BAR; PG8_SCHED;
            PG8_STAGE(PG8_SB(0, 1), b2 + hstep, voffB);
            PG8_WAIT_V(6); PG8_BAR; PG8_MMA(1, 1, At, B1); PG8_BAR;
            PG8_LDB(B0, 1, 0); PG8_SCHED; PG8_LDA(At, 1, 0); PG8_STAGE(PG8_SA(0, 1), a2 + hstep, voffA);
            PG8_WAIT_L(8); PG8_BAR; PG8_WAIT_L(0); PG8_MMA(0, 0, At, B0); PG8_BAR; PG8_SCHED;
            PG8_LDB(B1, 1, 1); PG8_STAGE(PG8_SB(1, 0), b3, voffB);
            PG8_BAR; PG8_WAIT_L(0); PG8_MMA(0, 1, At, B1); PG8_BAR;
            PG8_LDA(At, 1, 1); PG8_STAGE(PG8_SA(1, 0), a3, voffA);
            PG8_BAR; PG8_WAIT_L(0); PG8_MMA(1, 0, At, B0); PG8_BAR; PG8_SCHED;
            PG8_STAGE(PG8_SB(1, 1), b3 + hstep, voffB);
            PG8_WAIT_V(6); PG8_BAR; PG8_MMA(1, 1, At, B1); PG8_BAR;
            }
        }
        if constexpr (ALIGN_EPI) { if (wr == 0) PG8_BAR; }
        if constexpr (!Epi::AFTER_DRAIN) { E(acc, cur, wr, wc, fr, fq); S.done(cur); }
        if (!has_next) break;
#pragma unroll
        for (int a = 0; a < 2; ++a)
#pragma unroll
            for (int b = 0; b < 2; ++b)
#pragma unroll
                for (int m = 0; m < 4; ++m)
#pragma unroll
                    for (int n = 0; n < 2; ++n) acc[a][b][m][n] = (f32x4){0.f, 0.f, 0.f, 0.f};
        cur = nxt; cA = nA; cB = nB; ++ui;
        if constexpr (ALIGN_EPI) { if (wr == 1) PG8_BAR; }
    }
    PG8_WAIT_V(0);
    if constexpr (!ALIGN_EPI) { if (wr == 0) PG8_BAR; }
    PG8_BAR;
    if constexpr (Epi::AFTER_DRAIN) { E.fused(acc, cur, wr, wc, fr, fq, lds, wid, lane); S.done(cur); }
#undef PG8_SA
#undef PG8_SB
#undef PG8_STAGE
#undef PG8_LDA
#undef PG8_LDB
#undef PG8_MMA
#undef PG8_WAIT_V
#undef PG8_WAIT_L
#undef PG8_BAR
#undef PG8_SCHED
}
}
using pg8::bf16_t; using pg8::bf16x8; using pg8::f32x4; using pg8::u32x4; using pg8::u32x2; using pg8::cvt_pk_bf16; using pg8::bf_lo; using pg8::bf_hi;
typedef short s16x4 __attribute__((ext_vector_type(4)));
#define LAS __attribute__((address_space(3)))

constexpr int NB = 8, SEQ = 2048, DM = 2048, TOK = NB * SEQ, DFF = 8192;
constexpr int NWAVES = 8, NTHR = 512;
constexpr float DN_ALPHA = 1.4142135623730951f;
constexpr size_t MiB = 1u << 20;
constexpr size_t WS_ROPE = 0;
constexpr size_t WS_CTL2 = 507 * MiB;
constexpr size_t WS_BAR = WS_CTL2;
constexpr size_t WS_UC = WS_CTL2 + 16384;
constexpr int UC_U1 = 0, UC_C1 = 8192, UC_U2 = 16384, UC_C2 = 16384 + 1280, UC_U3 = 16384 + 2560, UC_C3 = 16384 + 2560 + 8192;
constexpr size_t WS_LNST = WS_CTL2 + 256 * 1024;
constexpr size_t WS_RMS = WS_CTL2 + 768 * 1024;
constexpr size_t WS_STATS = 1 * MiB;
constexpr size_t WS_GATESP = 2 * MiB;
constexpr size_t WS_W_IN = 7 * MiB;
constexpr size_t WS_W_AOUT = 31 * MiB;
constexpr size_t WS_W1_0 = 39 * MiB;
constexpr size_t WS_W2_0 = 71 * MiB;
constexpr size_t WS_W_DN = 103 * MiB;
constexpr size_t WS_W_KVUP = 108 * MiB;
constexpr size_t WS_W_QUP = 112 * MiB;
constexpr size_t WS_W_BOUT = 115 * MiB;
constexpr size_t WS_W1_1 = 123 * MiB;
constexpr size_t WS_W2_1 = 155 * MiB;
constexpr size_t WS_XA = 187 * MiB;
constexpr size_t WS_BIG = 251 * MiB;
constexpr size_t WS_XB = WS_BIG, WS_QK = WS_BIG + 64 * MiB, WS_V = WS_BIG + 128 * MiB, WS_O = WS_BIG + 192 * MiB;
constexpr size_t WS_KR = WS_BIG, WS_KN = WS_BIG + 2 * MiB, WS_VV = WS_BIG + 66 * MiB, WS_C = WS_BIG + 130 * MiB, WS_QL = WS_BIG + 146 * MiB, WS_AO = WS_BIG + 162 * MiB;
constexpr size_t WS_END = 508 * MiB;
constexpr int LDS_BYTES = 147456, LDS_MISC = 131072 + 512;

struct Params { const float* in[20]; float* out; unsigned char* ws; };
enum { I_X = 0, I_AWIN, I_ABG, I_ACW, I_ACB, I_ANW, I_AWOUT, I_KVWD, I_KVNW, I_KVWU, I_BWDQ, I_BQNW, I_BWUQ, I_BWOUT, I_W1, I_W2, I_L1G, I_L1B, I_L2G, I_L2B };

__device__ __forceinline__ unsigned f2bf(float f) { unsigned u = __builtin_bit_cast(unsigned, f); return (u + 0x7fffu + ((u >> 16) & 1u)) >> 16; }
__device__ __forceinline__ float bf2f(unsigned short h) { return __uint_as_float((unsigned)h << 16); }
__device__ __forceinline__ float wave_sum(float v) {
#pragma unroll
    for (int o = 1; o < 64; o <<= 1) v += __shfl_xor(v, o);
    return v;
}
__device__ __forceinline__ float wave_max(float v) {
#pragma unroll
    for (int o = 1; o < 64; o <<= 1) v = fmaxf(v, __shfl_xor(v, o));
    return v;
}
#define MFMA16(a, b, c) __builtin_amdgcn_mfma_f32_16x16x32_bf16((a), (b), (c), 0, 0, 0)

__device__ __forceinline__ int srccol(int mode, int n) {
    if (mode == 1) return 512 + ((n & 1) ? 32 + (n >> 1) : (n >> 1));
    if (mode == 2) { const int h = n / 192, j = n % 192; if (j < 128) return n; const int r = j - 128; return h * 192 + 128 + ((r & 1) ? 32 + (r >> 1) : (r >> 1)); }
    return n;
}
__device__ __forceinline__ float bf16_round(float x) { return __uint_as_float(f2bf(x) << 16); }
__device__ __forceinline__ void tr_item(const float* W, int ldw, int K, bf16_t* WT, int nblk, const float* kscale, int mode, float* scr, int item, int lane, float* uacc, float* cacc, const float* lnb) {
    const int kb = item / nblk, nb = item % nblk, k0 = 64 * kb, n0 = 32 * nb;
    const int sc = srccol(mode, n0 + (lane & 31));
    float us = 0.f, cs = 0.f;
#pragma unroll 8
    for (int i = 0; i < 32; ++i) { const int kk = 2 * i + (lane >> 5); const float w0 = W[(size_t)(k0 + kk) * ldw + sc]; float w = w0; if (kscale) w *= kscale[k0 + kk]; scr[kk * 33 + (lane & 31)] = w;
        if (uacc) { us += bf16_round(w); cs += lnb[k0 + kk] * w0; } }
    if (uacc) { us += __shfl_xor(us, 32); cs += __shfl_xor(cs, 32); if (lane < 32) { __hip_atomic_fetch_add(uacc + n0 + lane, us, __ATOMIC_RELAXED, __HIP_MEMORY_SCOPE_AGENT); __hip_atomic_fetch_add(cacc + n0 + lane, cs, __ATOMIC_RELAXED, __HIP_MEMORY_SCOPE_AGENT); } }
    asm volatile("s_waitcnt lgkmcnt(0)" ::: "memory"); asm volatile("" ::: "memory");
    const int c = lane & 7;
#pragma unroll
    for (int j = 0; j < 4; ++j) { const int n = (lane >> 3) + 8 * j; const float* s = scr + (8 * c) * 33 + n;
        u32x4 o; o.x = cvt_pk_bf16(s[0 * 33], s[1 * 33]); o.y = cvt_pk_bf16(s[2 * 33], s[3 * 33]); o.z = cvt_pk_bf16(s[4 * 33], s[5 * 33]); o.w = cvt_pk_bf16(s[6 * 33], s[7 * 33]);
        *(u32x4*)(WT + (size_t)(n0 + n) * K + k0 + 8 * c) = o; }
    asm volatile("s_waitcnt lgkmcnt(0)" ::: "memory"); asm volatile("" ::: "memory");
}
struct TrJob { const float* W; int ldw, K, nblk, r; bf16_t* WT; const float* ksc; float* ua; float* ca; const float* lb; };
__device__ __forceinline__ void tr64_load(const TrJob& j, f32x4 (&v)[16], int lane) {
    const int kb = j.r / j.nblk, nb = j.r % j.nblk, k0 = 64 * kb, n0 = 64 * nb, n4 = (lane & 15) * 4, kr = lane >> 4;
#pragma unroll
    for (int i = 0; i < 16; ++i) v[i] = *(const f32x4*)(j.W + (size_t)(k0 + kr + 4 * i) * j.ldw + n0 + n4);
}
__device__ __forceinline__ void tr64_process(const TrJob& j, const f32x4 (&v)[16], float* scr, int lane) {
    asm volatile("" : "+v"(lane));
    const int kb = j.r / j.nblk, nb = j.r % j.nblk, k0 = 64 * kb, n0 = 64 * nb, K = j.K;
    const int n4 = (lane & 15) * 4, kr = lane >> 4;
    const float* kscale = j.ksc; float* uacc = j.ua; float* cacc = j.ca; const float* lnb = j.lb; bf16_t* WT = j.WT;
    float us[4] = {0.f, 0.f, 0.f, 0.f}, cs[4] = {0.f, 0.f, 0.f, 0.f};
#pragma unroll
    for (int i = 0; i < 16; ++i) { const int kk = kr + 4 * i; const float s = kscale ? kscale[k0 + kk] : 1.0f; const float bb = uacc ? lnb[k0 + kk] : 0.f;
#pragma unroll
        for (int e = 0; e < 4; ++e) { const float xw = v[i][e] * s; scr[kk * 64 + ((n4 + e + kk) & 63)] = xw; us[e] += bf16_round(xw); cs[e] += bb * v[i][e]; } }
    if (uacc) {
#pragma unroll
        for (int e = 0; e < 4; ++e) { us[e] += __shfl_xor(us[e], 16); us[e] += __shfl_xor(us[e], 32); cs[e] += __shfl_xor(cs[e], 16); cs[e] += __shfl_xor(cs[e], 32); }
        if (lane < 16) {
#pragma unroll
            for (int e = 0; e < 4; ++e) { __hip_atomic_fetch_add(uacc + n0 + n4 + e, us[e], __ATOMIC_RELAXED, __HIP_MEMORY_SCOPE_AGENT); __hip_atomic_fetch_add(cacc + n0 + n4 + e, cs[e], __ATOMIC_RELAXED, __HIP_MEMORY_SCOPE_AGENT); } } }
    asm volatile("s_waitcnt lgkmcnt(0)" ::: "memory");
    const int c = lane & 7;
#pragma unroll
    for (int jj = 0; jj < 8; ++jj) { const int n = (lane >> 3) + 8 * jj; float r[8];
#pragma unroll
        for (int e = 0; e < 8; ++e) r[e] = scr[(8 * c + e) * 64 + ((n + 8 * c + e) & 63)];
        u32x4 o; o.x = cvt_pk_bf16(r[0], r[1]); o.y = cvt_pk_bf16(r[2], r[3]); o.z = cvt_pk_bf16(r[4], r[5]); o.w = cvt_pk_bf16(r[6], r[7]);
        *(u32x4*)(WT + (size_t)(n0 + n) * K + k0 + 8 * c) = o; }
    asm volatile("s_waitcnt lgkmcnt(0)" ::: "memory");
}
__device__ __forceinline__ void p0_prologue(const Params& p, unsigned char* lds) {
    int tid_ = threadIdx.x; asm volatile("" : "+v"(tid_)); const int tid = tid_, lane = tid & 63, wave = tid >> 6;
    const int gw = blockIdx.x * NWAVES + wave, NGW = gridDim.x * NWAVES;
    unsigned char* ws = p.ws;
    float* scr = (float*)(lds + wave * 16384);
    float* UC = (float*)(ws + WS_UC);
    constexpr int J0 = 32 * 96, J1 = 32 * 32, J2 = 32 * 128, J3 = 128 * 32, J4 = 32 * 8, J5 = 32 * 8, J7 = 8 * 64, J9 = 32 * 32, J10 = J2, J11 = J3;
    constexpr int NWIDE = J0 + J1 + J2 + J3 + J4 + J5 + J7 + J9 + J10 + J11;
#define TR_DECODE(job, it_) do { int r = (it_); job.ksc = nullptr; job.ua = nullptr; job.ca = nullptr; job.lb = nullptr; \
        if (r < J0) { job.W = p.in[I_AWIN]; job.ldw = 6160; job.K = 2048; job.WT = (bf16_t*)(ws + WS_W_IN); job.nblk = 96; } \
        else if ((r -= J0) < J1) { job.W = p.in[I_AWOUT]; job.ldw = 2048; job.K = 2048; job.WT = (bf16_t*)(ws + WS_W_AOUT); job.nblk = 32; } \
        else if ((r -= J1) < J2) { job.W = p.in[I_W1]; job.ldw = 8192; job.K = 2048; job.WT = (bf16_t*)(ws + WS_W1_0); job.nblk = 128; job.ksc = p.in[I_L1G]; job.lb = p.in[I_L1B]; job.ua = UC + UC_U1; job.ca = UC + UC_C1; } \
        else if ((r -= J2) < J3) { job.W = p.in[I_W2]; job.ldw = 2048; job.K = 8192; job.WT = (bf16_t*)(ws + WS_W2_0); job.nblk = 32; } \
        else if ((r -= J3) < J4) { job.W = p.in[I_KVWD]; job.ldw = 576; job.K = 2048; job.WT = (bf16_t*)(ws + WS_W_DN); job.nblk = 8; job.ksc = p.in[I_L2G]; job.lb = p.in[I_L2B]; job.ua = UC + UC_U2; job.ca = UC + UC_C2; } \
        else if ((r -= J4) < J5) { job.W = p.in[I_BWDQ]; job.ldw = 512; job.K = 2048; job.WT = (bf16_t*)(ws + WS_W_DN) + (size_t)512 * 2048; job.nblk = 8; job.ksc = p.in[I_L2G]; job.lb = p.in[I_L2B]; job.ua = UC + UC_U2 + 512; job.ca = UC + UC_C2 + 512; } \
        else if ((r -= J5) < J7) { job.W = p.in[I_KVWU]; job.ldw = 4096; job.K = 512; job.WT = (bf16_t*)(ws + WS_W_KVUP); job.nblk = 64; job.ksc = p.in[I_KVNW]; } \
        else if ((r -= J7) < J9) { job.W = p.in[I_BWOUT]; job.ldw = 2048; job.K = 2048; job.WT = (bf16_t*)(ws + WS_W_BOUT); job.nblk = 32; } \
        else if ((r -= J9) < J10) { job.W = p.in[I_W1] + (size_t)2048 * 8192; job.ldw = 8192; job.K = 2048; job.WT = (bf16_t*)(ws + WS_W1_1); job.nblk = 128; job.ksc = p.in[I_L1G] + 2048; job.lb = p.in[I_L1B] + 2048; job.ua = UC + UC_U3; job.ca = UC + UC_C3; } \
        else { r -= J10; job.W = p.in[I_W2] + (size_t)8192 * 2048; job.ldw = 2048; job.K = 8192; job.WT = (bf16_t*)(ws + WS_W2_1); job.nblk = 32; } \
        job.r = r; } while (0)
    if (gw < NWIDE) {
        TrJob cur; TR_DECODE(cur, gw); f32x4 vc[16]; tr64_load(cur, vc, lane);
        for (int it = gw; it < NWIDE; it += NGW) {
            const int nx = it + NGW; TrJob nxt = cur; f32x4 vn[16];
            if (nx < NWIDE) { TR_DECODE(nxt, nx); tr64_load(nxt, vn, lane); }
            tr64_process(cur, vc, scr, lane);
            if (nx < NWIDE) { cur = nxt;
#pragma unroll
                for (int i = 0; i < 16; ++i) vc[i] = vn[i]; }
        }
    }
#undef TR_DECODE
    { constexpr int J6 = 32 * 2, J8 = 8 * 96;
      for (int it = gw; it < J6 + J8; it += NGW) {
          if (it < J6) tr_item(p.in[I_KVWD], 576, 2048, (bf16_t*)(ws + WS_W_DN) + (size_t)1024 * 2048, 2, p.in[I_L2G], 1, scr, it, lane, UC + UC_U2 + 1024, UC + UC_C2 + 1024, p.in[I_L2B]);
          else tr_item(p.in[I_BWUQ], 3072, 512, (bf16_t*)(ws + WS_W_QUP), 96, p.in[I_BQNW], 2, scr, it - J6, lane, nullptr, nullptr, nullptr); } }
    { u32x4* z = (u32x4*)((bf16_t*)(ws + WS_W_DN) + (size_t)1088 * 2048); const int n16 = 192 * 2048 * 2 / 16;
      for (int i = blockIdx.x * NTHR + tid; i < n16; i += gridDim.x * NTHR) z[i] = (u32x4){0u, 0u, 0u, 0u}; }
    { float* rope = (float*)(ws + WS_ROPE);
      for (int idx = blockIdx.x * NTHR + tid; idx < 2048 * 32; idx += gridDim.x * NTHR) {
          const int pos = idx >> 5, i = idx & 31;
          double f = 1.0; for (int k = 0; k < i; ++k) f *= 0.74989420933245582730;
          const double ang = (double)pos * f;
          const double n = __builtin_rint(ang * 0.15915494309189533577);
          double r = __builtin_fma(-n, 6.283185307179586232, ang); r = __builtin_fma(-n, 2.449293598294706414e-16, r);
          const double qd = __builtin_rint(r * 0.63661977236758134308); const int qi = (int)qd;
          double t = __builtin_fma(-qd, 1.5707963267948965580, r); t = __builtin_fma(-qd, 6.123233995736766036e-17, t);
          const double t2 = t * t;
          double sp = -1.0 / 1307674368000.0; sp = sp * t2 + 1.0 / 6227020800.0; sp = sp * t2 - 1.0 / 39916800.0; sp = sp * t2 + 1.0 / 362880.0; sp = sp * t2 - 1.0 / 5040.0; sp = sp * t2 + 1.0 / 120.0; sp = sp * t2 - 1.0 / 6.0; sp = sp * t2 + 1.0;
          const double st = sp * t;
          double cp = 1.0 / 20922789888000.0; cp = cp * t2 - 1.0 / 87178291200.0; cp = cp * t2 + 1.0 / 479001600.0; cp = cp * t2 - 1.0 / 3628800.0; cp = cp * t2 + 1.0 / 40320.0; cp = cp * t2 - 1.0 / 720.0; cp = cp * t2 + 1.0 / 24.0; cp = cp * t2 - 0.5; cp = cp * t2 + 1.0;
          const int qm = qi & 3; double sv, cv;
          if (qm == 0) { sv = st; cv = cp; } else if (qm == 1) { sv = cp; cv = -st; } else if (qm == 2) { sv = -st; cv = -cp; } else { sv = -cp; cv = st; }
          rope[idx * 2] = (float)cv; rope[idx * 2 + 1] = (float)sv; } }
    { const float* x = p.in[I_X]; const float* win = p.in[I_AWIN]; bf16_t* XB = (bf16_t*)(ws + WS_XB); float* GP = (float*)(ws + WS_GATESP);
      const int fr = lane & 15, fq = lane >> 4;
      bf16_t* wgT = (bf16_t*)lds; constexpr int WGS = 2056;
      __syncthreads();
      for (int i = tid; i < 2048 * 4; i += NTHR) { const int k = i >> 2, g4 = (i & 3) * 4; const f32x4 wq = *(const f32x4*)(win + (size_t)k * 6160 + 6144 + g4);
          const unsigned u0 = cvt_pk_bf16(wq[0], wq[1]), u1 = cvt_pk_bf16(wq[2], wq[3]);
          wgT[(g4 + 0) * WGS + k] = (bf16_t)u0; wgT[(g4 + 1) * WGS + k] = (bf16_t)(u0 >> 16); wgT[(g4 + 2) * WGS + k] = (bf16_t)u1; wgT[(g4 + 3) * WGS + k] = (bf16_t)(u1 >> 16); }
      __syncthreads();
      for (int task = gw; task < 4096; task += NGW) {
          const int g16 = task >> 2, kq = task & 3; const int row = g16 * 16 + fr;
          f32x4 acc = {0.f, 0.f, 0.f, 0.f};
          const float* xp = x + (size_t)row * 2048 + kq * 512 + 8 * fq; bf16_t* xo = XB + (size_t)row * 2048 + kq * 512 + 8 * fq; const bf16_t* wl = wgT + fr * WGS + kq * 512 + 8 * fq;
#pragma unroll 8
          for (int s = 0; s < 16; ++s) {
              const f32x4 a0 = *(const f32x4*)(xp + 32 * s), a1 = *(const f32x4*)(xp + 32 * s + 4);
              const u32x4 aw = pg8::pack8(a0, a1);
              *(u32x4*)(xo + 32 * s) = aw;
              acc = MFMA16(__builtin_bit_cast(bf16x8, aw), *(const bf16x8*)(wl + 32 * s), acc);
          }
#pragma unroll
          for (int i = 0; i < 4; ++i) GP[((size_t)kq * TOK + g16 * 16 + 4 * fq + i) * 16 + fr] = acc[i];
      } }
}
__device__ __forceinline__ float wave_scan_add(float v, int lane) {
#pragma unroll
    for (int o = 1; o < 64; o <<= 1) { const float t = __shfl_up(v, o); if (lane >= o) v += t; }
    return v;
}
__device__ __forceinline__ float wave_scan_max(float v, int lane) {
#pragma unroll
    for (int o = 1; o < 64; o <<= 1) { const float t = __shfl_up(v, o); if (lane >= o) v = fmaxf(v, t); }
    return v;
}
constexpr int GV_RT = 0, GV_CT = 131072, GV_WI = 262144, GV_EN = 393216, GV_WK = 524288, GV_DEC = 655360;
__device__ __forceinline__ void conv_phase(const Params& p) {
    int tid_ = threadIdx.x; asm volatile("" : "+v"(tid_)); const int tid = tid_, lane = tid & 63, wave = tid >> 6;
    { const int gwave = blockIdx.x * NWAVES + wave;
      if ((gwave & 31) == 0) { const int bh = gwave >> 5, b = bh >> 3, h = bh & 7;
          const float* GP = (const float*)(p.ws + WS_GATESP); const float* bg = p.in[I_ABG]; float* GV = (float*)p.out;
          const float bi = bg[h], bf = bg[8 + h]; float m_old = 0.f;
          for (int cb = 0; cb < 32; cb += 8) {
              float ivs[8], fps[8];
#pragma unroll
              for (int j = 0; j < 8; ++j) { const size_t gr = ((size_t)b * SEQ + (cb + j) * 64 + lane) * 16; float iv = bi, fp = bf;
#pragma unroll
                  for (int q = 0; q < 4; ++q) { iv += GP[(size_t)q * TOK * 16 + gr + h]; fp += GP[(size_t)q * TOK * 16 + gr + 8 + h]; }
                  ivs[j] = iv; fps[j] = fp; }
#pragma unroll
              for (int j = 0; j < 8; ++j) { const int c = cb + j, tk = c * 64 + lane; const float iv = ivs[j], fp = fps[j];
                  const float logf = fminf(fp, 0.f) - __logf(1.0f + __expf(-fabsf(fp)));
                  const float bcum = wave_scan_add(logf, lane);
                  const float g = __shfl(bcum, 63);
                  const float ct = iv - bcum;
                  const float pm = wave_scan_max(ct, lane);
                  const float cmax = __shfl(pm, 63);
                  const float mt = fmaxf(bcum + pm, bcum + m_old);
                  const float rt = bcum - mt;
                  const float mnew = g + fmaxf(m_old, cmax);
                  const size_t o = (size_t)bh * 2048 + tk;
                  GV[GV_RT + o] = rt; GV[GV_CT + o] = ct; GV[GV_WI + o] = __expf(rt + m_old); GV[GV_EN + o] = __expf(-mt); GV[GV_WK + o] = __expf(g + ct - mnew);
                  if (lane == 0) GV[GV_DEC + bh * 32 + c] = __expf(g + m_old - mnew);
                  m_old = mnew; } } } }
    const bf16_t* QK = (const bf16_t*)(p.ws + WS_QK); bf16_t* QKc = (bf16_t*)(p.ws + WS_XB);
    const float* convw = p.in[I_ACW]; const float* convb = p.in[I_ACB];
    for (int idx = blockIdx.x * NTHR + tid; idx < TOK * 256; idx += gridDim.x * NTHR) {
        const int tok = idx >> 8, ch = (idx & 255) * 8, spos = tok & 2047;
        const f32x4 b0 = *(const f32x4*)(convb + ch), b1 = *(const f32x4*)(convb + ch + 4);
        float a8[8] = {b0[0], b0[1], b0[2], b0[3], b1[0], b1[1], b1[2], b1[3]};
#pragma unroll
        for (int j = 0; j < 4; ++j) {
            if (spos - 3 + j >= 0) { const u32x4 raw = *(const u32x4*)(QK + (size_t)(tok - 3 + j) * 2048 + ch);
                const f32x4 w0 = *(const f32x4*)(convw + j * 2048 + ch), w1 = *(const f32x4*)(convw + j * 2048 + ch + 4);
                a8[0] += bf_lo(raw.x) * w0[0]; a8[1] += bf_hi(raw.x) * w0[1]; a8[2] += bf_lo(raw.y) * w0[2]; a8[3] += bf_hi(raw.y) * w0[3];
                a8[4] += bf_lo(raw.z) * w1[0]; a8[5] += bf_hi(raw.z) * w1[1]; a8[6] += bf_lo(raw.w) * w1[2]; a8[7] += bf_hi(raw.w) * w1[3]; } }
        const float sc = (ch >= 1024) ? 1.0f : 0.08838834764831845f;
#pragma unroll
        for (int e = 0; e < 8; ++e) a8[e] = a8[e] / (1.0f + __expf(-a8[e])) * sc;
        u32x4 o; o.x = cvt_pk_bf16(a8[0], a8[1]); o.y = cvt_pk_bf16(a8[2], a8[3]); o.z = cvt_pk_bf16(a8[4], a8[5]); o.w = cvt_pk_bf16(a8[6], a8[7]);
        { const int isk = ch >> 10, hh = (ch & 1023) >> 7, cl = ch & 127;
          *(u32x4*)(QKc + ((size_t)(isk * 64 + (tok >> 11) * 8 + hh) * 2048 + spos) * 128 + cl) = o; }
    }
}
__device__ __forceinline__ void mlstm_phase(const Params& p, unsigned char* lds) {
    int tid_ = threadIdx.x; asm volatile("" : "+v"(tid_)); const int tid = tid_, lane = tid & 63, w = tid >> 6, fr = lane & 15, fq = lane >> 4;
    constexpr int QS = 144, VS = 80;
    bf16_t* q_s = (bf16_t*)lds;
    bf16_t* k_s = q_s + 64 * QS;
    bf16_t* vT = k_s + 64 * QS;
    bf16_t* kwT = vT + 80 * VS;
    bf16_t* CT_s = kwT + 128 * VS;
    const bf16_t* QKc = (const bf16_t*)(p.ws + WS_XB); const bf16_t* V = (const bf16_t*)(p.ws + WS_V); bf16_t* H = (bf16_t*)(p.ws + WS_XA);
    const float* GV = (const float*)p.out;
    { const int item = blockIdx.x;
        const int bh = item >> 2, sl = item & 3, b = bh >> 3, h = bh & 7;
        __syncthreads();
        for (int i = tid; i < 2 * 80 * QS; i += NTHR) CT_s[i] = 0;
        for (int i = tid; i < 16 * VS; i += NTHR) vT[64 * VS + i] = (i < VS) ? (bf16_t)0x3F80 : (bf16_t)0;
        f32x4 Cacc[5];
#pragma unroll
        for (int i = 0; i < 5; ++i) Cacc[i] = (f32x4){0.f, 0.f, 0.f, 0.f};
        const int t0 = tid >> 4, cg0 = tid & 15, sv = tid >> 3, vg = tid & 7, tt = w & 3, vt0 = (w < 4) ? 0 : 2;
        const bf16_t* qsrc = QKc + ((size_t)bh * 2048 + t0) * 128 + cg0 * 8;
        const bf16_t* vsrc = V + ((size_t)(bh * 4 + sl) * 2048 + sv) * 64 + vg * 8;
        const float* gvb = GV + (size_t)bh * 2048;
        u32x4 rq0, rq1, rk0, rk1, rv; float wk0, wk1, rt_t, wi_t, en_t, dec; f32x4 ctv[4];
#define ML_LOAD(c) do { const size_t o_ = (size_t)(c) * 64 * 128; rq0 = *(const u32x4*)(qsrc + o_); rq1 = *(const u32x4*)(qsrc + o_ + 32 * 128); rk0 = *(const u32x4*)(qsrc + o_ + (size_t)TOK * 1024); rk1 = *(const u32x4*)(qsrc + o_ + 32 * 128 + (size_t)TOK * 1024); \
            rv = *(const u32x4*)(vsrc + (size_t)(c) * 64 * 64); const float* g_ = gvb + (c) * 64; wk0 = g_[GV_WK + t0]; wk1 = g_[GV_WK + t0 + 32]; rt_t = g_[GV_RT + 16 * tt + fr]; wi_t = g_[GV_WI + 16 * tt + fr]; en_t = g_[GV_EN + 16 * tt + fr]; \
            dec = GV[GV_DEC + bh * 32 + (c)]; _Pragma("unroll") for (int st_ = 0; st_ < 4; ++st_) ctv[st_] = *(const f32x4*)(g_ + GV_CT + 16 * st_ + 4 * fq); } while (0)
#define ML_BAR() asm volatile("s_waitcnt lgkmcnt(0)\n\ts_barrier" ::: "memory")
        ML_LOAD(0);
        __syncthreads();
        for (int c = 0; c < 32; ++c) {
            const size_t rowc = (size_t)b * SEQ + c * 64;
            const bf16_t* Ccur = CT_s + (c & 1) * 80 * QS; bf16_t* Cnxt = CT_s + ((c + 1) & 1) * 80 * QS;
            *(u32x4*)(q_s + t0 * QS + cg0 * 8) = rq0; *(u32x4*)(q_s + (t0 + 32) * QS + cg0 * 8) = rq1;
            *(u32x4*)(k_s + t0 * QS + cg0 * 8) = rk0; *(u32x4*)(k_s + (t0 + 32) * QS + cg0 * 8) = rk1;
            { bf16_t* d = vT + (vg * 8) * VS + sv;
              d[0] = (bf16_t)rv.x; d[VS] = (bf16_t)(rv.x >> 16); d[2 * VS] = (bf16_t)rv.y; d[3 * VS] = (bf16_t)(rv.y >> 16);
              d[4 * VS] = (bf16_t)rv.z; d[5 * VS] = (bf16_t)(rv.z >> 16); d[6 * VS] = (bf16_t)rv.w; d[7 * VS] = (bf16_t)(rv.w >> 16); }
            { bf16_t* d = kwT + (cg0 * 8) * VS + t0; unsigned u_;
              u_ = cvt_pk_bf16(bf_lo(rk0.x) * wk0, bf_hi(rk0.x) * wk0); d[0] = (bf16_t)u_; d[VS] = (bf16_t)(u_ >> 16);
              u_ = cvt_pk_bf16(bf_lo(rk0.y) * wk0, bf_hi(rk0.y) * wk0); d[2 * VS] = (bf16_t)u_; d[3 * VS] = (bf16_t)(u_ >> 16);
              u_ = cvt_pk_bf16(bf_lo(rk0.z) * wk0, bf_hi(rk0.z) * wk0); d[4 * VS] = (bf16_t)u_; d[5 * VS] = (bf16_t)(u_ >> 16);
              u_ = cvt_pk_bf16(bf_lo(rk0.w) * wk0, bf_hi(rk0.w) * wk0); d[6 * VS] = (bf16_t)u_; d[7 * VS] = (bf16_t)(u_ >> 16);
              d += 32;
              u_ = cvt_pk_bf16(bf_lo(rk1.x) * wk1, bf_hi(rk1.x) * wk1); d[0] = (bf16_t)u_; d[VS] = (bf16_t)(u_ >> 16);
              u_ = cvt_pk_bf16(bf_lo(rk1.y) * wk1, bf_hi(rk1.y) * wk1); d[2 * VS] = (bf16_t)u_; d[3 * VS] = (bf16_t)(u_ >> 16);
              u_ = cvt_pk_bf16(bf_lo(rk1.z) * wk1, bf_hi(rk1.z) * wk1); d[4 * VS] = (bf16_t)u_; d[5 * VS] = (bf16_t)(u_ >> 16);
              u_ = cvt_pk_bf16(bf_lo(rk1.w) * wk1, bf_hi(rk1.w) * wk1); d[6 * VS] = (bf16_t)u_; d[7 * VS] = (bf16_t)(u_ >> 16); }
            const float rt_c = rt_t, wi_c = wi_t, en_c = en_t, dec_c = dec; f32x4 ct_c[4];
#pragma unroll
            for (int i = 0; i < 4; ++i) ct_c[i] = ctv[i];
            if (c + 1 < 32) ML_LOAD(c + 1);
            ML_BAR();
            bf16x8 qfr[4];
#pragma unroll
            for (int ks = 0; ks < 4; ++ks) qfr[ks] = *(const bf16x8*)(q_s + (16 * tt + fr) * QS + 32 * ks + 8 * fq);
            f32x4 P[4];
#pragma unroll
            for (int st = 0; st < 4; ++st) { f32x4 acc = {0.f, 0.f, 0.f, 0.f};
                if (st <= tt) {
#pragma unroll
                    for (int ks = 0; ks < 4; ++ks) { const bf16x8 A = *(const bf16x8*)(k_s + (16 * st + fr) * QS + 32 * ks + 8 * fq); acc = MFMA16(A, qfr[ks], acc); } }
                const int tq = 16 * tt + fr;
#pragma unroll
                for (int i = 0; i < 4; ++i) { const int s = 16 * st + 4 * fq + i; P[st][i] = (s <= tq) ? acc[i] * __expf(rt_c + ct_c[st][i]) : 0.f; } }
            bf16x8 pf[2];
            pf[0] = __builtin_bit_cast(bf16x8, pg8::pack8(P[0], P[1])); pf[1] = __builtin_bit_cast(bf16x8, pg8::pack8(P[2], P[3]));
            f32x4 num[3];
#pragma unroll
            for (int vi = 0; vi < 3; ++vi) { const int vt = (vi < 2) ? vt0 + vi : 4; f32x4 a1 = {0.f, 0.f, 0.f, 0.f}, a2 = {0.f, 0.f, 0.f, 0.f};
#pragma unroll
                for (int k2 = 0; k2 < 2; ++k2) { const s16x4 lo = *(const s16x4*)(vT + (16 * vt + fr) * VS + 32 * k2 + 4 * fq), hi = *(const s16x4*)(vT + (16 * vt + fr) * VS + 32 * k2 + 16 + 4 * fq);
                    const bf16x8 A = __builtin_shufflevector(lo, hi, 0, 1, 2, 3, 4, 5, 6, 7); a1 = MFMA16(A, pf[k2], a1); }
#pragma unroll
                for (int ks = 0; ks < 4; ++ks) { const bf16x8 A = *(const bf16x8*)(Ccur + (16 * vt + fr) * QS + 32 * ks + 8 * fq); a2 = MFMA16(A, qfr[ks], a2); }
                num[vi] = a1 + a2 * wi_c; }
            { const float den = __shfl(num[2][0], fr);
              const float rinv = 1.0f / fmaxf(fabsf(den), en_c);
#pragma unroll
              for (int vi = 0; vi < 2; ++vi) { u32x2 r; r.x = cvt_pk_bf16(num[vi][0] * rinv, num[vi][1] * rinv); r.y = cvt_pk_bf16(num[vi][2] * rinv, num[vi][3] * rinv);
                  *(u32x2*)(H + (rowc + 16 * tt + fr) * 2048 + h * 256 + sl * 64 + 16 * (vt0 + vi) + 4 * fq) = r; } }
#pragma unroll
            for (int vt = 0; vt < 5; ++vt) { f32x4 a = Cacc[vt] * dec_c;
#pragma unroll
                for (int ks = 0; ks < 2; ++ks) { const bf16x8 A = *(const bf16x8*)(vT + (16 * vt + fr) * VS + 32 * ks + 8 * fq), B = *(const bf16x8*)(kwT + (16 * w + fr) * VS + 32 * ks + 8 * fq); a = MFMA16(A, B, a); }
                Cacc[vt] = a;
#pragma unroll
                for (int i = 0; i < 0; ++i) {}
                { bf16_t* d = Cnxt + (16 * vt + 4 * fq) * QS + 16 * w + fr; const unsigned u0 = cvt_pk_bf16(a[0], a[1]), u1 = cvt_pk_bf16(a[2], a[3]);
                  d[0] = (bf16_t)u0; d[QS] = (bf16_t)(u0 >> 16); d[2 * QS] = (bf16_t)u1; d[3 * QS] = (bf16_t)(u1 >> 16); } }
            ML_BAR();
        }
#undef ML_LOAD
#undef ML_BAR
    }
}
__device__ __forceinline__ void gate_phase(const Params& p) {
    int tid_ = threadIdx.x; asm volatile("" : "+v"(tid_)); const int tid = tid_, lane = tid & 63, wave = tid >> 6;
    const int gw = blockIdx.x * NWAVES + wave, NGW = gridDim.x * NWAVES;
    const bf16_t* H = (const bf16_t*)(p.ws + WS_XA); const bf16_t* O = (const bf16_t*)(p.ws + WS_O); bf16_t* HG = (bf16_t*)(p.ws + WS_QK);
    const float* nw = p.in[I_ANW];
    for (int tok = gw; tok < TOK; tok += NGW) {
#pragma unroll 2
        for (int h = 0; h < 8; ++h) { const size_t off = (size_t)tok * 2048 + h * 256 + lane * 4;
            const u32x2 hw = *(const u32x2*)(H + off), ow = *(const u32x2*)(O + off);
            const float h0 = bf_lo(hw.x), h1 = bf_hi(hw.x), h2 = bf_lo(hw.y), h3 = bf_hi(hw.y);
            const float mu = wave_sum((h0 + h1) + (h2 + h3)) * (1.0f / 256.0f);
            const float d0 = h0 - mu, d1 = h1 - mu, d2 = h2 - mu, d3 = h3 - mu;
            const float var = wave_sum((d0 * d0 + d1 * d1) + (d2 * d2 + d3 * d3)) * (1.0f / 256.0f);
            const float rstd = 1.0f / sqrtf(var + 1e-5f);
            const f32x4 g = *(const f32x4*)(nw + h * 256 + lane * 4);
            const float o0 = bf_lo(ow.x), o1 = bf_hi(ow.x), o2 = bf_lo(ow.y), o3 = bf_hi(ow.y);
            u32x2 r; r.x = cvt_pk_bf16(d0 * rstd * g[0] / (1.0f + __expf(-o0)), d1 * rstd * g[1] / (1.0f + __expf(-o1)));
            r.y = cvt_pk_bf16(d2 * rstd * g[2] / (1.0f + __expf(-o2)), d3 * rstd * g[3] / (1.0f + __expf(-o3)));
            *(u32x2*)(HG + off) = r; }
    }
}
template <bool OUTF32> __device__ __forceinline__ void ln_phase(const float* Y, const float* g, const float* bta, void* out) {
    int tid_ = threadIdx.x; asm volatile("" : "+v"(tid_)); const int tid = tid_, lane = tid & 63, wave = tid >> 6;
    const int gw = blockIdx.x * NWAVES + wave, NGW = gridDim.x * NWAVES;
    for (int row = gw; row < TOK; row += NGW) {
        const f32x4* yr = (const f32x4*)(Y + (size_t)row * 2048) + lane;
        f32x4 v[8]; float s = 0.f;
#pragma unroll
        for (int j = 0; j < 8; ++j) { v[j] = yr[64 * j]; s += (v[j][0] + v[j][1]) + (v[j][2] + v[j][3]); }
        const float mean = wave_sum(s) * (1.0f / 2048.0f); float s2 = 0.f;
#pragma unroll
        for (int j = 0; j < 8; ++j) { v[j] = v[j] - mean; s2 += (v[j][0] * v[j][0] + v[j][1] * v[j][1]) + (v[j][2] * v[j][2] + v[j][3] * v[j][3]); }
        const float rstd = 1.0f / sqrtf(wave_sum(s2) * (1.0f / 2048.0f) + 1e-5f);
#pragma unroll
        for (int j = 0; j < 8; ++j) { const int col = (lane + 64 * j) * 4; const f32x4 gg = *(const f32x4*)(g + col), bb = *(const f32x4*)(bta + col);
            const f32x4 o = v[j] * rstd * gg + bb;
            if (OUTF32) *(f32x4*)((float*)out + (size_t)row * 2048 + col) = o;
            else { u32x2 r; r.x = cvt_pk_bf16(o[0], o[1]); r.y = cvt_pk_bf16(o[2], o[3]); *(u32x2*)((bf16_t*)out + (size_t)row * 2048 + col) = r; } }
    }
}
__device__ __forceinline__ void ln_final_phase(const bf16_t* Y, const float* st, const float* g, const float* bta, float* out) {
    int tid_ = threadIdx.x; asm volatile("" : "+v"(tid_)); const int tid = tid_, lane = tid & 63, wave = tid >> 6;
    const int gw = blockIdx.x * NWAVES + wave, NGW = gridDim.x * NWAVES;
    for (int row = gw; row < TOK; row += NGW) {
        float mu, rstd; pg8::ln_row(st, row, mu, rstd);
#pragma unroll
        for (int j = 0; j < 4; ++j) { const int col = (lane + 64 * j) * 8; const u32x4 w = *(const u32x4*)(Y + (size_t)row * 2048 + col);
            const f32x4 y0 = {bf_lo(w.x), bf_hi(w.x), bf_lo(w.y), bf_hi(w.y)}, y1 = {bf_lo(w.z), bf_hi(w.z), bf_lo(w.w), bf_hi(w.w)};
            const f32x4 g0 = *(const f32x4*)(g + col), g1 = *(const f32x4*)(g + col + 4), b0 = *(const f32x4*)(bta + col), b1 = *(const f32x4*)(bta + col + 4);
            *(f32x4*)(out + (size_t)row * 2048 + col) = (y0 - mu) * rstd * g0 + b0; *(f32x4*)(out + (size_t)row * 2048 + col + 4) = (y1 - mu) * rstd * g1 + b1; }
    }
}
typedef short v4i16_t __attribute__((ext_vector_type(4)));
__device__ __forceinline__ s16x4 lds_tr(const bf16_t* ptr) { return __builtin_bit_cast(s16x4, __builtin_amdgcn_ds_read_tr16_b64_v4i16((LAS v4i16_t*)ptr)); }
constexpr int AT_KS = 200, AT_VS = 144, AT_KB = 64 * AT_KS, AT_VB = 64 * AT_VS;
__device__ __forceinline__ void attn_phase(const Params& p, unsigned char* lds) {
    int tid_ = threadIdx.x; asm volatile("" : "+v"(tid_)); const int tid = tid_, lane = tid & 63, w = tid >> 6, fr = lane & 15, fq = lane >> 4;
    bf16_t* LK = (bf16_t*)lds;
    bf16_t* LV = LK + 2 * AT_KB;
    const bf16_t* Q = (const bf16_t*)p.out; const bf16_t* KN = (const bf16_t*)(p.ws + WS_KN); const bf16_t* VV = (const bf16_t*)(p.ws + WS_VV); const bf16_t* KR = (const bf16_t*)(p.ws + WS_KR);
    bf16_t* AO = (bf16_t*)(p.ws + WS_AO);
    const int key0 = tid >> 4, cg0 = tid & 15, keyr = tid >> 3, cgr = tid & 7;
    const bool late = (w >= 4);
    { const int wg = blockIdx.x;
        const int bh = wg >> 1, par = wg & 1, b = bh >> 4, h = bh & 15;
        const bf16_t* KNb = KN + ((size_t)bh * 2048 + key0) * 128 + cg0 * 8;
        const bf16_t* VVb = VV + ((size_t)bh * 2048 + key0) * 128 + cg0 * 8;
        const bf16_t* KRb = KR + (size_t)b * SEQ * 64 + (size_t)keyr * 64 + cgr * 8;
        for (int ui = 0; ui < 4; ++ui) {
            const int j = par * 2 + (ui >> 1), qb = (ui & 1) ? 7 - j : j;
            const size_t row0 = (size_t)b * SEQ + qb * 256 + 32 * w;
            bf16x8 qf[2][6];
#pragma unroll
            for (int qi = 0; qi < 2; ++qi)
#pragma unroll
                for (int ks = 0; ks < 6; ++ks) qf[qi][ks] = *(const bf16x8*)(Q + (row0 + 16 * qi + fr) * 3072 + h * 192 + 32 * ks + 8 * fq);
            f32x4 oacc[2][8];
#pragma unroll
            for (int qi = 0; qi < 2; ++qi)
#pragma unroll
                for (int i = 0; i < 8; ++i) oacc[qi][i] = (f32x4){0.f, 0.f, 0.f, 0.f};
            float mrow[2] = {-1e30f, -1e30f}, lsum[2] = {0.f, 0.f};
            f32x4 sacc[2][4];
            const int ntile = 4 * qb + 4, mylast = 4 * qb + (w >> 1);
            u32x4 pk0, pk1, pkr, pv0, pv1;
#define AT_LOAD(t) do { const size_t o_ = (size_t)(t) * 64 * 128; pk0 = *(const u32x4*)(KNb + o_); pk1 = *(const u32x4*)(KNb + o_ + 32 * 128); pkr = *(const u32x4*)(KRb + (size_t)(t) * 64 * 64); \
                pv0 = *(const u32x4*)(VVb + o_); pv1 = *(const u32x4*)(VVb + o_ + 32 * 128); } while (0)
#define AT_STORE(kbi, vbi) do { bf16_t* Kd = LK + (kbi) * AT_KB; bf16_t* Vd = LV + (vbi) * AT_VB; *(u32x4*)(Kd + key0 * AT_KS + cg0 * 8) = pk0; *(u32x4*)(Kd + (key0 + 32) * AT_KS + cg0 * 8) = pk1; \
                *(u32x4*)(Kd + keyr * AT_KS + 128 + cgr * 8) = pkr; *(u32x4*)(Vd + key0 * AT_VS + cg0 * 8) = pv0; *(u32x4*)(Vd + (key0 + 32) * AT_VS + cg0 * 8) = pv1; } while (0)
#define AT_S(kbi) do { const bf16_t* Kt = LK + (kbi) * AT_KB; \
                _Pragma("unroll") for (int kt = 0; kt < 4; ++kt) { sacc[0][kt] = (f32x4){0.f, 0.f, 0.f, 0.f}; sacc[1][kt] = (f32x4){0.f, 0.f, 0.f, 0.f}; \
                    _Pragma("unroll") for (int ks = 0; ks < 6; ++ks) { const bf16x8 A = *(const bf16x8*)(Kt + (16 * kt + fr) * AT_KS + 32 * ks + 8 * fq); \
                        sacc[0][kt] = MFMA16(A, qf[0][ks], sacc[0][kt]); sacc[1][kt] = MFMA16(A, qf[1][ks], sacc[1][kt]); } asm volatile("" ::: "memory"); } } while (0)
#define AT_PV(vbi) do { const bf16_t* Vt = LV + (vbi) * AT_VB; bf16x8 pf[2][2]; \
                _Pragma("unroll") for (int qi = 0; qi < 2; ++qi) { float mx = -1e30f; \
                    _Pragma("unroll") for (int kt = 0; kt < 4; ++kt) mx = fmaxf(mx, fmaxf(fmaxf(sacc[qi][kt][0], sacc[qi][kt][1]), fmaxf(sacc[qi][kt][2], sacc[qi][kt][3]))); \
                    mx = fmaxf(mx, __shfl_xor(mx, 16)); mx = fmaxf(mx, __shfl_xor(mx, 32)); \
                    if (__any(mx > mrow[qi] + 8.0f)) {     \
                        const float mnew = fmaxf(mrow[qi], mx), alpha = __builtin_amdgcn_exp2f(mrow[qi] - mnew); mrow[qi] = mnew; lsum[qi] *= alpha; \
                        _Pragma("unroll") for (int vt = 0; vt < 8; ++vt) oacc[qi][vt] = oacc[qi][vt] * alpha; } \
                    const float mref = mrow[qi]; float ps = 0.f; \
                    _Pragma("unroll") for (int kt = 0; kt < 4; ++kt) _Pragma("unroll") for (int i = 0; i < 4; ++i) { const float e = __builtin_amdgcn_exp2f(sacc[qi][kt][i] - mref); sacc[qi][kt][i] = e; ps += e; } \
                    lsum[qi] += ps; \
                    pf[qi][0] = __builtin_bit_cast(bf16x8, pg8::pack8(sacc[qi][0], sacc[qi][1])); pf[qi][1] = __builtin_bit_cast(bf16x8, pg8::pack8(sacc[qi][2], sacc[qi][3])); } \
                const bf16_t* vb = Vt + (4 * fq + (fr >> 2)) * AT_VS + 4 * (fr & 3); \
                _Pragma("unroll") for (int vt = 0; vt < 8; ++vt) _Pragma("unroll") for (int k2 = 0; k2 < 2; ++k2) { const s16x4 lo = lds_tr(vb + (32 * k2) * AT_VS + 16 * vt), hi = lds_tr(vb + (32 * k2 + 16) * AT_VS + 16 * vt); \
                    const bf16x8 A = {lo[0], lo[1], lo[2], lo[3], hi[0], hi[1], hi[2], hi[3]}; \
                    oacc[0][vt] = MFMA16(A, pf[0][k2], oacc[0][vt]); oacc[1][vt] = MFMA16(A, pf[1][k2], oacc[1][vt]); if (k2 == 1) asm volatile("" ::: "memory"); } } while (0)
            AT_LOAD(0);
            __syncthreads();
            AT_STORE(0, 0);
            __builtin_amdgcn_s_waitcnt(0x0F70);
            __syncthreads();
            int vs = 0;
            for (int t = 0; t < ntile; ++t) {
                const int vnext = (vs == 2) ? 0 : vs + 1, vprev = (vs == 0) ? 2 : vs - 1;
                if (t + 1 < ntile) AT_LOAD(t + 1);
                if (late && t >= 1 && t - 1 <= mylast) AT_PV(vprev);
                if (t <= mylast) { AT_S(t & 1); if (!late) AT_PV(vs); }
                if (t + 1 < ntile) AT_STORE((t + 1) & 1, vnext);
                __syncthreads();
                vs = vnext;
            }
            if (late && ntile - 1 <= mylast) { const int vlast = (vs == 0) ? 2 : vs - 1; AT_PV(vlast); }
#undef AT_LOAD
#undef AT_STORE
#undef AT_S
#undef AT_PV
#pragma unroll
            for (int qi = 0; qi < 2; ++qi) { float l = lsum[qi]; l += __shfl_xor(l, 16); l += __shfl_xor(l, 32);
                const float inv = 1.0f / l;
#pragma unroll
                for (int vt = 0; vt < 8; ++vt) { u32x2 r; r.x = cvt_pk_bf16(oacc[qi][vt][0] * inv, oacc[qi][vt][1] * inv); r.y = cvt_pk_bf16(oacc[qi][vt][2] * inv, oacc[qi][vt][3] * inv);
                    *(u32x2*)(AO + (row0 + 16 * qi + fr) * 2048 + h * 128 + 16 * vt + 4 * fq) = r; } }
        }
    }
}
__device__ __forceinline__ void krope_phase(const Params& p) {
    int tid_ = threadIdx.x; asm volatile("" : "+v"(tid_)); const int tid = tid_, lane = tid & 63, w = tid >> 6, fr = lane & 15, fq = lane >> 4;
    const bf16_t* XA = (const bf16_t*)(p.ws + WS_XA); const bf16_t* WR = (const bf16_t*)(p.ws + WS_W_DN) + (size_t)1024 * 2048;
    const float* ST2 = (const float*)(p.ws + WS_LNST) + 2 * TOK; const float* UC = (const float*)(p.ws + WS_UC); const float* rope = (const float*)(p.ws + WS_ROPE);
    bf16_t* KR = (bf16_t*)(p.ws + WS_KR);
    const int tok0 = blockIdx.x * 64 + (w & 3) * 16, c0 = (w >> 2) * 32;
    const bf16_t* ap = XA + (size_t)(tok0 + fr) * 2048 + 8 * fq;
    const bf16_t* bp0 = WR + (size_t)(c0 + fr) * 2048 + 8 * fq; const bf16_t* bp1 = bp0 + (size_t)16 * 2048;
    f32x4 a0 = {0.f, 0.f, 0.f, 0.f}, a1 = {0.f, 0.f, 0.f, 0.f};
#pragma unroll 8
    for (int ks = 0; ks < 64; ++ks) { const bf16x8 A = *(const bf16x8*)(ap + 32 * ks); a0 = MFMA16(A, *(const bf16x8*)(bp0 + 32 * ks), a0); a1 = MFMA16(A, *(const bf16x8*)(bp1 + 32 * ks), a1); }
#pragma unroll
    for (int nt = 0; nt < 2; ++nt) { const int col = c0 + 16 * nt + fr; const float uu = UC[UC_U2 + 1024 + col], cc = UC[UC_C2 + 1024 + col];
#pragma unroll
        for (int i = 0; i < 4; ++i) { const int row = tok0 + 4 * fq + i; float mu, rstd; pg8::ln_row(ST2, row, mu, rstd);
            const float v = ((nt ? a1[i] : a0[i]) - mu * uu) * rstd + cc; const float o = __shfl_xor(v, 1);
            const float cs = rope[((size_t)(row & 2047) * 32 + (col >> 1)) * 2], sn = rope[((size_t)(row & 2047) * 32 + (col >> 1)) * 2 + 1];
            const float r = (col & 1) ? (v * cs + o * sn) : (v * cs - o * sn);
            KR[(size_t)row * 64 + col] = (bf16_t)f2bf(r); } }
}
#define XB_TMO      128
#define XB_XCNT(j)  (256  + 64 * (j))
#define XB_XSUB(j)  (1280 + 64 * (j))
#define XB_XGEN(j)  (2304 + 64 * (j))
#define XB_TOP      3328
#define XB_TOPGEN   3392
#define XCD_BAR_WORDS 3456
#define XB_SPIN_CAP (1u << 18)

__device__ __forceinline__ unsigned xb_ld(unsigned* p)              { return __hip_atomic_load(p, __ATOMIC_RELAXED, __HIP_MEMORY_SCOPE_AGENT); }
__device__ __forceinline__ unsigned xb_add(unsigned* p, unsigned v) { return __hip_atomic_fetch_add(p, v, __ATOMIC_RELAXED, __HIP_MEMORY_SCOPE_AGENT); }
__device__ __forceinline__ unsigned xb_xcc_id() { return (unsigned)__builtin_amdgcn_s_getreg((3 << 11) | 20) & 0xFu; }
#define XB_SPIN(cond, bar) do { unsigned _sp = 0; while (cond) { __builtin_amdgcn_s_sleep(1); \
    if ((++_sp & 255u) == 0u) { if (xb_ld(&(bar)[XB_TMO])) break; if (_sp > XB_SPIN_CAP) { atomicAdd(&(bar)[XB_TMO], 1u); break; } } } } while (0)

struct XcdBarrier {
    unsigned* bar; unsigned x;
    volatile LAS unsigned* st;
};

__device__ __forceinline__ XcdBarrier xcd_barrier_post(unsigned* bar, volatile LAS unsigned* st) {
    XcdBarrier b; b.bar = bar; b.x = xb_xcc_id(); b.st = st;
    if (threadIdx.x == 0) (void)xb_add(&bar[XB_XCNT(b.x)], 1u);
    return b;
}
__device__ __forceinline__ void xcd_barrier_complete(unsigned* bar, unsigned x, unsigned& nloc, unsigned& nx) {
    const unsigned G = gridDim.x * gridDim.y * gridDim.z;
    unsigned sum, cnt, mine, sp = 0u;
    for (;;) {
        sum = 0u; cnt = 0u; mine = 0u;
#pragma unroll
        for (unsigned j = 0; j < 16; ++j) { const unsigned c = xb_ld(&bar[XB_XCNT(j)]); sum += c; cnt += (c > 0u) ? 1u : 0u; mine = (j == x) ? c : mine; }
        if (sum == G) break;
        __builtin_amdgcn_s_sleep(1);
        if ((++sp & 255u) == 0u) { if (xb_ld(&bar[XB_TMO])) break; if (sp > XB_SPIN_CAP) { atomicAdd(&bar[XB_TMO], 1u); break; } }
    }
    nloc = mine > 0u ? mine : 1u; nx = cnt > 0u ? cnt : 1u;
}

__device__ __forceinline__ void xcd_barrier(const XcdBarrier& b) {
    asm volatile("s_waitcnt vmcnt(0)" ::: "memory");
    __syncthreads();
    if (threadIdx.x == 0) {
        unsigned* bar = b.bar;
        __builtin_amdgcn_s_waitcnt(0);
        unsigned nloc = b.st[0], nx = b.st[1];
        if (nloc == 0u) { xcd_barrier_complete(bar, b.x, nloc, nx); b.st[0] = nloc; b.st[1] = nx; }
        const unsigned old = xb_add(&bar[XB_XSUB(b.x)], 1u);
        const unsigned gen = old / nloc;
        if (old + 1u == (gen + 1u) * nloc) {
            __builtin_amdgcn_fence(__ATOMIC_RELEASE, "agent");
            asm volatile("s_waitcnt vmcnt(0)" ::: "memory");
            const unsigned og = xb_add(&bar[XB_TOP], 1u);
            const unsigned tg = og / nx;
            if (og + 1u == (tg + 1u) * nx) xb_add(&bar[XB_TOPGEN], 1u);
            else XB_SPIN(xb_ld(&bar[XB_TOPGEN]) == tg, bar);
            __builtin_amdgcn_fence(__ATOMIC_ACQUIRE, "agent");
            xb_add(&bar[XB_XGEN(b.x)], 1u);
            asm volatile("s_waitcnt vmcnt(0)" ::: "memory");
        } else {
            XB_SPIN(xb_ld(&bar[XB_XGEN(b.x)]) == gen, bar);
            __builtin_amdgcn_fence(__ATOMIC_ACQUIRE, "agent");
            asm volatile("s_waitcnt vmcnt(0)" ::: "memory");
        }
    }
    __syncthreads();
}

#ifndef REP_ATTN
#define REP_ATTN 1
#endif
#ifndef REP_MLSTM
#define REP_MLSTM 1
#endif
#ifndef REP_P0
#define REP_P0 1
#endif
__device__ __forceinline__ int opq(int v) { asm volatile("" : "+s"(v)); return v; }
#define GSYNC() xcd_barrier(xbar)
template <int LAYER> __device__ __forceinline__ void layer_body(const Params& p, unsigned char* lds, const XcdBarrier& xbar) {
    LAS unsigned char* ldsl = (LAS unsigned char*)lds;
    unsigned char* ws = p.ws;
    const int G = (int)gridDim.x, bx = (int)blockIdx.x;
    bf16_t* XA = (bf16_t*)(ws + WS_XA); bf16_t* HID = (bf16_t*)(ws + WS_BIG);
    float* ST1 = (float*)(ws + WS_LNST), *ST2 = ST1 + 2 * TOK, *ST3 = ST2 + 2 * TOK;
    const float* UC = (const float*)(ws + WS_UC);
    if (LAYER == 1) {
        krope_phase(p);
        { pg8::Gemm g{XA, (const bf16_t*)(ws + WS_W_DN), TOK, 1024, opq(2048)}; pg8::StaticOrder S; S.init(TOK, 1024, G, bx);
          pg8::EpiDown E{(bf16_t*)(ws + WS_C), (bf16_t*)(ws + WS_QL), (bf16_t*)(ws + WS_KR), (float*)(ws + WS_RMS), (const float*)(ws + WS_ROPE), ST2, UC + UC_U2, UC + UC_C2};
          pg8::gemm_phase<pg8::EpiDown, pg8::StaticOrder, true, true>(ldsl, g, S, E); }
        GSYNC();
        { pg8::Gemm g{(const bf16_t*)(ws + WS_C), (const bf16_t*)(ws + WS_W_KVUP), TOK, 4096, opq(512)}; pg8::StaticOrder S; S.init(TOK, 4096, G, bx);
          pg8::EpiKvUp E{(bf16_t*)(ws + WS_KN), (bf16_t*)(ws + WS_VV), (const float*)(ws + WS_RMS)};
          pg8::gemm_phase<pg8::EpiKvUp, pg8::StaticOrder, true, true>(ldsl, g, S, E); }
        { pg8::Gemm g{(const bf16_t*)(ws + WS_QL), (const bf16_t*)(ws + WS_W_QUP), TOK, 3072, opq(512)}; pg8::StaticOrder S; S.init(TOK, 3072, G, bx);
          pg8::EpiQUp E{(bf16_t*)p.out, (const float*)(ws + WS_RMS), (const float*)(ws + WS_ROPE), 0.10411754627697264f};
          pg8::gemm_phase<pg8::EpiQUp, pg8::StaticOrder, true, true>(ldsl, g, S, E); }
        GSYNC();
        attn_phase(p, lds);
#if REP_ATTN > 1
        attn_phase(p, lds);
#endif
        GSYNC();
    }
    if (LAYER == 0) {
        pg8::Gemm g{(const bf16_t*)(ws + WS_QK), (const bf16_t*)(ws + WS_W_AOUT), TOK, 2048, opq(2048)}; pg8::StaticOrder S; S.init(TOK, 2048, G, bx);
        pg8::EpiFirst E{p.in[I_X], XA, ST1, DN_ALPHA};
        pg8::gemm_phase<pg8::EpiFirst, pg8::StaticOrder, true, true>(ldsl, g, S, E);
    } else {
        pg8::Gemm g{(const bf16_t*)(ws + WS_AO), (const bf16_t*)(ws + WS_W_BOUT), TOK, 2048, opq(2048)}; pg8::StaticOrder S; S.init(TOK, 2048, G, bx);
        pg8::EpiResLn<false> E{XA, ST2, p.in[I_L2G], p.in[I_L2B], ST3, nullptr, DN_ALPHA};
        pg8::gemm_phase<pg8::EpiResLn<false>, pg8::StaticOrder, true, true>(ldsl, g, S, E);
    }
    GSYNC();
    { pg8::Gemm g{XA, (const bf16_t*)(ws + (LAYER ? WS_W1_1 : WS_W1_0)), TOK, DFF, opq(2048)}; pg8::StaticOrder S; S.init(TOK, DFF, G, bx);
      pg8::EpiUpLn E{HID, DFF, LAYER ? ST3 : ST1, UC + (LAYER ? UC_U3 : UC_U1), UC + (LAYER ? UC_C3 : UC_C1)};
      pg8::gemm_phase<pg8::EpiUpLn, pg8::StaticOrder, true, true>(ldsl, g, S, E); }
    GSYNC();
    if (LAYER == 0) {
        pg8::Gemm g{HID, (const bf16_t*)(ws + WS_W2_0), TOK, 2048, opq(DFF)}; pg8::StaticOrder S; S.init(TOK, 2048, G, bx);
        pg8::EpiResLn<false> E{XA, ST1, p.in[I_L1G], p.in[I_L1B], ST2, nullptr, DN_ALPHA};
        pg8::gemm_phase<pg8::EpiResLn<false>, pg8::StaticOrder, true, true>(ldsl, g, S, E);
        GSYNC();
    } else {
        pg8::Gemm g{HID, (const bf16_t*)(ws + WS_W2_1), TOK, 2048, opq(DFF)}; pg8::StaticOrder S; S.init(TOK, 2048, G, bx);
        pg8::EpiResLn<false> E{XA, ST3, p.in[I_L1G] + 2048, p.in[I_L1B] + 2048, ST3 + 2 * TOK, nullptr, DN_ALPHA};
        pg8::gemm_phase<pg8::EpiResLn<false>, pg8::StaticOrder, true, true>(ldsl, g, S, E);
        GSYNC();
        ln_final_phase(XA, ST3 + 2 * TOK, p.in[I_L2G] + 2048, p.in[I_L2B] + 2048, p.out);
    }
}
__global__ void __launch_bounds__(NTHR, 2) yoco_fwd(Params p) {
    extern __shared__ __attribute__((aligned(16))) unsigned char lds[];
    cg::grid_group grid = cg::this_grid();
    unsigned* barw = (unsigned*)(p.ws + WS_BAR);
    volatile LAS unsigned* stw = (volatile LAS unsigned*)((LAS unsigned char*)lds + LDS_MISC);
    if (threadIdx.x < 2) stw[threadIdx.x] = 0u;
    __syncthreads();
    const XcdBarrier xbar = xcd_barrier_post(barw, stw);
    if (p.ws == nullptr) grid.sync();
    p0_prologue(p, lds);
#if REP_P0 > 1
    p0_prologue(p, lds);
#endif
    GSYNC();
    { pg8::Gemm g{(const bf16_t*)(p.ws + WS_XB), (const bf16_t*)(p.ws + WS_W_IN), TOK, 6144, opq(2048)}; pg8::StaticOrder S; S.init(TOK, 6144, (int)gridDim.x, (int)blockIdx.x);
      pg8::EpiSplitBf16<0> E{(bf16_t*)(p.ws + WS_QK), 2048, 8, (size_t)(64 * MiB / 2), 1};
      pg8::gemm_phase<pg8::EpiSplitBf16<0>, pg8::StaticOrder, true, true>((LAS unsigned char*)lds, g, S, E); }
    GSYNC();
    conv_phase(p);
    GSYNC();
    mlstm_phase(p, lds);
#if REP_MLSTM > 1
    mlstm_phase(p, lds);
#endif
    GSYNC();
#ifndef SKIP_GATE
    gate_phase(p);
#endif
    GSYNC();
    layer_body<0>(p, lds, xbar);
    layer_body<1>(p, lds, xbar);
}

extern "C" void kernel_launch(void* const* d_in, const int* in_sizes, int n_in, void* d_out, int out_size, void* d_ws, size_t ws_size, hipStream_t stream) {
    static int grid = 0;
    if (grid == 0) {
        if (n_in != 20 || out_size != TOK * DM || ws_size < WS_END) { fprintf(stderr, "kernel_launch: unexpected shapes: n_in %d out %d ws %zu (need %zu)\n", n_in, out_size, ws_size, (size_t)WS_END); grid = -1; return; }
        int dev = 0, cus = 0, per_cu = 0;
        hipGetDevice(&dev); hipDeviceGetAttribute(&cus, hipDeviceAttributeMultiprocessorCount, dev);
        if (hipFuncSetAttribute((const void*)yoco_fwd, hipFuncAttributeMaxDynamicSharedMemorySize, LDS_BYTES) != hipSuccess) { fprintf(stderr, "kernel_launch: hipFuncSetAttribute failed\n"); grid = -1; return; }
        if (hipOccupancyMaxActiveBlocksPerMultiprocessor(&per_cu, (const void*)yoco_fwd, NTHR, LDS_BYTES) != hipSuccess || per_cu < 1) { fprintf(stderr, "kernel_launch: occupancy query gave %d\n", per_cu); per_cu = 1; }
        (void)hipGetLastError();
        grid = cus * per_cu;
        if (grid > 256) grid = 256;
        if (grid != 256) { fprintf(stderr, "kernel_launch: this kernel needs exactly 256 resident workgroups, got %d\n", grid); grid = -1; return; }
    }
    if (grid < 0) return;
    if (hipMemsetAsync((char*)d_ws + WS_CTL2, 0, MiB, stream) != hipSuccess) { fprintf(stderr, "kernel_launch: memset failed\n"); return; }
    Params p{};
    for (int i = 0; i < 20; ++i) p.in[i] = (const float*)d_in[i];
    p.out = (float*)d_out; p.ws = (unsigned char*)d_ws;
    void* args[] = {&p};
    hipError_t e = hipLaunchCooperativeKernel((const void*)yoco_fwd, dim3(grid), dim3(NTHR), args, LDS_BYTES, stream);
    if (e != hipSuccess) fprintf(stderr, "cooperative launch failed: %s (grid %d)\n", hipGetErrorString(e), grid);
}
```

```cpp
#include <hip/hip_runtime.h>
#include <hip/hip_cooperative_groups.h>
#include <cstdio>
#include <cstdint>
namespace cg = cooperative_groups;
#ifndef WGM_P1
#define WGM_P1 2
#endif
#ifndef WGM_UP
#define WGM_UP 4
#endif
#ifndef WGM_N2K
#define WGM_N2K 4
#endif
#ifndef WGM_DN
#define WGM_DN 4
#endif
#ifndef WGM_KV
#define WGM_KV 4
#endif
#ifndef WGM_Q
#define WGM_Q 4
#endif
namespace pg8 {
#define PG8_LAS __attribute__((address_space(3)))
typedef unsigned short bf16_t;
typedef short bf16x8 __attribute__((ext_vector_type(8)));
typedef float f32x4 __attribute__((ext_vector_type(4)));
typedef unsigned u32x4 __attribute__((ext_vector_type(4)));
constexpr int BM = 256, BK = 64, HALF = 128, HTB = HALF * BK * 2  , STAGE_BYTES = 8 * HTB, NXCD = 8, WGM = 4;

__host__ __device__ __forceinline__ int lds_byte(int r, int c) { const int st = (r >> 4) * 2 + (c >> 5), rr = r & 15, cc = c & 31, ob = rr * 64 + cc * 2; return st * 1024 + (ob ^ (((ob >> 9) & 1) << 5)); }
__host__ __device__ __forceinline__ void stage_rc(int b, int& R, int& C) { const int st = b / 1024, sb = b % 1024, swz = sb ^ (((sb >> 9) & 1) << 5); R = (st >> 1) * 16 + swz / 64; C = (st & 1) * 32 + (swz % 64) / 2; }
__host__ __device__ __forceinline__ int perm32(int rho) { const int n = rho >> 4, i = rho & 15; return 8 * (i >> 2) + 4 * n + (i & 3); }

struct Unit { int pm, pn; };
struct Gemm { const bf16_t* A; const bf16_t* Bt; int M, N, K; };

struct StaticOrder {
    int nM, nN, nwg, G, c, wgm;
    __host__ __device__ void init(int M, int N, int G_, int c_, int wgm_ = 4) { nM = M / BM; nN = N / BM; nwg = nM * nN; G = G_; c = c_; wgm = wgm_; }
    __host__ __device__ bool next(int i, Unit& u) const {
        const long L = (long)i * G + c; if (L >= nwg) return false;
        int wgid = (int)L; { const int q = nwg / NXCD, r = nwg % NXCD, xcd = wgid % NXCD, off = wgid / NXCD; wgid = (xcd < r ? xcd * (q + 1) : r * (q + 1) + (xcd - r) * q) + off; }
        const int nig = wgm * nN, gid = wgid / nig, fm = gid * wgm, gsz = (nM - fm) < wgm ? (nM - fm) : wgm;
        u.pm = fm + ((wgid % nig) % gsz); u.pn = (wgid % nig) / gsz; return true;
    }
    __device__ __forceinline__ void a_ready(const Unit&) const {}
    __device__ __forceinline__ void done(const Unit&) const {}
};

typedef float f32x2c_t __attribute__((ext_vector_type(2))); typedef __bf16 bf16x2c_t __attribute__((ext_vector_type(2)));
__device__ __forceinline__ unsigned cvt_pk_bf16(float lo, float hi) { const f32x2c_t v = {lo, hi}; const bf16x2c_t b = __builtin_convertvector(v, bf16x2c_t); return __builtin_bit_cast(unsigned, b); }
typedef float f32x2 __attribute__((ext_vector_type(2)));
typedef unsigned u32x2 __attribute__((ext_vector_type(2)));
__device__ __forceinline__ float bf_lo(unsigned w) { return __uint_as_float(w << 16); }
__device__ __forceinline__ float bf_hi(unsigned w) { return __uint_as_float(w & 0xffff0000u); }
__device__ __forceinline__ u32x4 pack8(const f32x4 a, const f32x4 b) { u32x4 w; w.x = cvt_pk_bf16(a[0], a[1]); w.y = cvt_pk_bf16(a[2], a[3]); w.z = cvt_pk_bf16(b[0], b[1]); w.w = cvt_pk_bf16(b[2], b[3]); return w; }
#define EPI_LOOP_BEGIN \
    _Pragma("unroll") for (int ai = 0; ai < 2; ++ai) _Pragma("unroll") for (int m = 0; m < 4; ++m) { const int row = u.pm * BM + ai * HALF + wr * 64 + m * 16 + fr; \
    _Pragma("unroll") for (int bj = 0; bj < 2; ++bj) { const int col0 = u.pn * BM + bj * HALF + wc * 32 + 8 * fq; const f32x4 v0 = acc[ai][bj][m][0], v1 = acc[ai][bj][m][1];
#define EPI_LOOP_END } asm volatile("" ::: "memory"); }
template <int ACT> struct EpiSplitBf16 {
    static constexpr bool PERM = true, AFTER_DRAIN = false;
    bf16_t* O; int ldc; int tiles_per; size_t split_stride; int vperm;
    __device__ __forceinline__ void operator()(const f32x4 (&acc)[2][2][4][2], const Unit& u, int wr, int wc, int fr, int fq) const {
        const int t = u.pn / tiles_per; bf16_t* base = O + (size_t)t * split_stride; const int csub = t * tiles_per * BM;
        EPI_LOOP_BEGIN
            f32x4 a = v0, b = v1;
            if (ACT == 1) {
#pragma unroll
                for (int e = 0; e < 4; ++e) { const float x = fmaxf(a[e], 0.f), y = fmaxf(b[e], 0.f); a[e] = x * x; b[e] = y * y; } }
            if (vperm && t == 1) { const int cl_ = col0 - csub;
                *(u32x4*)(base + ((size_t)((row >> 11) * 32 + (cl_ >> 6)) * 2048 + (row & 2047)) * 64 + (cl_ & 63)) = pack8(a, b); }
            else *(u32x4*)(base + (size_t)row * ldc + (col0 - csub)) = pack8(a, b);
        EPI_LOOP_END
    }
};
template <bool RBF16> struct EpiResid {
    static constexpr bool PERM = true, AFTER_DRAIN = false;
    const void* R; float* Y; int ldc; float alpha;
    __device__ __forceinline__ void operator()(const f32x4 (&acc)[2][2][4][2], const Unit& u, int wr, int wc, int fr, int fq) const {
        EPI_LOOP_BEGIN
            const size_t off = (size_t)row * ldc + col0; f32x4 r0, r1;
            if (RBF16) { const u32x4 w = *(const u32x4*)((const bf16_t*)R + off); r0 = (f32x4){bf_lo(w.x), bf_hi(w.x), bf_lo(w.y), bf_hi(w.y)}; r1 = (f32x4){bf_lo(w.z), bf_hi(w.z), bf_lo(w.w), bf_hi(w.w)}; }
            else { r0 = *(const f32x4*)((const float*)R + off); r1 = *(const f32x4*)((const float*)R + off + 4); }
            *(f32x4*)(Y + off) = r0 * alpha + v0; *(f32x4*)(Y + off + 4) = r1 * alpha + v1;
        EPI_LOOP_END
    }
};

__device__ __forceinline__ void ln_row(const float* st, int row, float& mu, float& rstd) {
    const float s = st[2 * (size_t)row], q = st[2 * (size_t)row + 1]; mu = s * (1.0f / 2048.0f);
    const float var = fmaxf(q * (1.0f / 2048.0f) - mu * mu, 0.f); rstd = 1.0f / sqrtf(var + 1e-5f);
}
__device__ __forceinline__ float sum8(const f32x4 a, const f32x4 b) { return ((a[0] + a[1]) + (a[2] + a[3])) + ((b[0] + b[1]) + (b[2] + b[3])); }
__device__ __forceinline__ float ssq8(const f32x4 a, const f32x4 b) { return ((a[0] * a[0] + a[1] * a[1]) + (a[2] * a[2] + a[3] * a[3])) + ((b[0] * b[0] + b[1] * b[1]) + (b[2] * b[2] + b[3] * b[3])); }
#define ROWSTATS_FLUSH(stn) do { _Pragma("unroll") for (int ri = 0; ri < 8; ++ri) { float s_ = rs[ri], q_ = rq[ri]; s_ += __shfl_xor(s_, 16); s_ += __shfl_xor(s_, 32); q_ += __shfl_xor(q_, 16); q_ += __shfl_xor(q_, 32); \
        if (fq == 0) { const int row_ = u.pm * BM + (ri >> 2) * HALF + wr * 64 + (ri & 3) * 16 + fr; __hip_atomic_fetch_add((stn) + 2 * (size_t)row_, s_, __ATOMIC_RELAXED, __HIP_MEMORY_SCOPE_AGENT); __hip_atomic_fetch_add((stn) + 2 * (size_t)row_ + 1, q_, __ATOMIC_RELAXED, __HIP_MEMORY_SCOPE_AGENT); } } } while (0)
struct EpiFirst {
    static constexpr bool PERM = true, AFTER_DRAIN = false;
    const float* X; bf16_t* Y; float* stn; float alpha;
    __device__ __forceinline__ void operator()(const f32x4 (&acc)[2][2][4][2], const Unit& u, int wr, int wc, int fr, int fq) const {
        float rs[8], rq[8];
#pragma unroll
        for (int i = 0; i < 8; ++i) { rs[i] = 0.f; rq[i] = 0.f; }
#pragma unroll
        for (int bj = 0; bj < 2; ++bj) { const int col0 = u.pn * BM + bj * HALF + wc * 32 + 8 * fq;
#pragma unroll
            for (int ai = 0; ai < 2; ++ai)
#pragma unroll
                for (int m = 0; m < 4; ++m) { const int row = u.pm * BM + ai * HALF + wr * 64 + m * 16 + fr; const size_t off = (size_t)row * 2048 + col0;
                    const f32x4 y0 = *(const f32x4*)(X + off) * alpha + acc[ai][bj][m][0], y1 = *(const f32x4*)(X + off + 4) * alpha + acc[ai][bj][m][1];
                    rs[ai * 4 + m] += sum8(y0, y1); rq[ai * 4 + m] += ssq8(y0, y1);
                    *(u32x4*)(Y + off) = pack8(y0, y1); asm volatile("" ::: "memory"); } }
        ROWSTATS_FLUSH(stn);
    }
};
template <bool LAST> struct EpiResLn {
    static constexpr bool PERM = true, AFTER_DRAIN = false;
    bf16_t* XA; const float* stp; const float* g; const float* b; float* stn; float* Yf; float alpha;
    __device__ __forceinline__ void operator()(const f32x4 (&acc)[2][2][4][2], const Unit& u, int wr, int wc, int fr, int fq) const {
        float rs[8], rq[8], mu8[8], rstd8[8];
#pragma unroll
        for (int i = 0; i < 8; ++i) { rs[i] = 0.f; rq[i] = 0.f; ln_row(stp, u.pm * BM + (i >> 2) * HALF + wr * 64 + (i & 3) * 16 + fr, mu8[i], rstd8[i]); }
#pragma unroll
        for (int bj = 0; bj < 2; ++bj) { const int col0 = u.pn * BM + bj * HALF + wc * 32 + 8 * fq;
            const f32x4 g0 = *(const f32x4*)(g + col0), g1 = *(const f32x4*)(g + col0 + 4), b0 = *(const f32x4*)(b + col0), b1 = *(const f32x4*)(b + col0 + 4);
#pragma unroll
            for (int ai = 0; ai < 2; ++ai)
#pragma unroll
                for (int m = 0; m < 4; ++m) { const int ri = ai * 4 + m; const int row = u.pm * BM + ai * HALF + wr * 64 + m * 16 + fr; const size_t off = (size_t)row * 2048 + col0;
                    const u32x4 w = *(const u32x4*)(XA + off);
                    const f32x4 p0 = {bf_lo(w.x), bf_hi(w.x), bf_lo(w.y), bf_hi(w.y)}, p1 = {bf_lo(w.z), bf_hi(w.z), bf_lo(w.w), bf_hi(w.w)};
                    const f32x4 y0 = ((p0 - mu8[ri]) * rstd8[ri] * g0 + b0) * alpha + acc[ai][bj][m][0], y1 = ((p1 - mu8[ri]) * rstd8[ri] * g1 + b1) * alpha + acc[ai][bj][m][1];
                    if (LAST) { *(f32x4*)(Yf + off) = y0; *(f32x4*)(Yf + off + 4) = y1; }
                    else { rs[ri] += sum8(y0, y1); rq[ri] += ssq8(y0, y1); *(u32x4*)(XA + off) = pack8(y0, y1); }
                    asm volatile("" ::: "memory"); } }
        if (!LAST) ROWSTATS_FLUSH(stn);
    }
};
struct EpiUpLn {
    static constexpr bool PERM = true, AFTER_DRAIN = false;
    bf16_t* O; int ldc; const float* st; const float* uv; const float* cv;
    __device__ __forceinline__ void operator()(const f32x4 (&acc)[2][2][4][2], const Unit& u, int wr, int wc, int fr, int fq) const {
        float mu8[8], rstd8[8];
#pragma unroll
        for (int i = 0; i < 8; ++i) ln_row(st, u.pm * BM + (i >> 2) * HALF + wr * 64 + (i & 3) * 16 + fr, mu8[i], rstd8[i]);
#pragma unroll
        for (int bj = 0; bj < 2; ++bj) { const int col0 = u.pn * BM + bj * HALF + wc * 32 + 8 * fq;
            const f32x4 u0 = *(const f32x4*)(uv + col0), u1 = *(const f32x4*)(uv + col0 + 4), c0 = *(const f32x4*)(cv + col0), c1 = *(const f32x4*)(cv + col0 + 4);
#pragma unroll
            for (int ai = 0; ai < 2; ++ai)
#pragma unroll
                for (int m = 0; m < 4; ++m) { const int ri = ai * 4 + m; const int row = u.pm * BM + ai * HALF + wr * 64 + m * 16 + fr;
                    f32x4 a = (acc[ai][bj][m][0] - u0 * mu8[ri]) * rstd8[ri] + c0, bb = (acc[ai][bj][m][1] - u1 * mu8[ri]) * rstd8[ri] + c1;
#pragma unroll
                    for (int e = 0; e < 4; ++e) { const float x = fmaxf(a[e], 0.f), y = fmaxf(bb[e], 0.f); a[e] = x * x; bb[e] = y * y; }
                    *(u32x4*)(O + (size_t)row * ldc + col0) = pack8(a, bb); asm volatile("" ::: "memory"); } }
    }
};
struct EpiDown {
    static constexpr bool PERM = true, AFTER_DRAIN = false;
    bf16_t* C; bf16_t* QL; bf16_t* KR; float* stats; const float* rope;
    const float* st; const float* uv; const float* cv;
    __device__ __forceinline__ void operator()(const f32x4 (&acc)[2][2][4][2], const Unit& u, int wr, int wc, int fr, int fq) const {
        if (u.pn < 4) {
            bf16_t* base = (u.pn < 2) ? C : QL; const int csub = (u.pn < 2) ? 0 : 512;
#pragma unroll
            for (int ai = 0; ai < 2; ++ai)
#pragma unroll
                for (int m = 0; m < 4; ++m) { const int row = u.pm * BM + ai * HALF + wr * 64 + m * 16 + fr; float ss = 0.f; float mu, rstd; ln_row(st, row, mu, rstd);
#pragma unroll
                    for (int bj = 0; bj < 2; ++bj) { const int col0 = u.pn * BM + bj * HALF + wc * 32 + 8 * fq;
                        const f32x4 v0 = (acc[ai][bj][m][0] - *(const f32x4*)(uv + col0) * mu) * rstd + *(const f32x4*)(cv + col0), v1 = (acc[ai][bj][m][1] - *(const f32x4*)(uv + col0 + 4) * mu) * rstd + *(const f32x4*)(cv + col0 + 4);
                        ss += (v0[0] * v0[0] + v0[1] * v0[1]) + (v0[2] * v0[2] + v0[3] * v0[3]) + (v1[0] * v1[0] + v1[1] * v1[1]) + (v1[2] * v1[2] + v1[3] * v1[3]);
                        *(u32x4*)(base + (size_t)row * 512 + (col0 - csub)) = pack8(v0, v1); }
                    ss += __shfl_xor(ss, 16); ss += __shfl_xor(ss, 32);
                    if (fq == 0) __hip_atomic_fetch_add(stats + (size_t)row * 2 + (u.pn >> 1), ss, __ATOMIC_RELAXED, __HIP_MEMORY_SCOPE_AGENT);
                    asm volatile("" ::: "memory"); }
        } else {
#pragma unroll
            for (int ai = 0; ai < 2; ++ai)
#pragma unroll
                for (int m = 0; m < 4; ++m) { const int row = u.pm * BM + ai * HALF + wr * 64 + m * 16 + fr; const int pos = row & 2047;
                    const int c = wc * 32 + 8 * fq;
                    if (c < 64) { float mu, rstd; ln_row(st, row, mu, rstd); const f32x4 v0 = (acc[ai][0][m][0] - *(const f32x4*)(uv + 1024 + c) * mu) * rstd + *(const f32x4*)(cv + 1024 + c), v1 = (acc[ai][0][m][1] - *(const f32x4*)(uv + 1024 + c + 4) * mu) * rstd + *(const f32x4*)(cv + 1024 + c + 4); const f32x4 cs0 = *(const f32x4*)(rope + ((size_t)pos * 32 + (c >> 1)) * 2), cs1 = *(const f32x4*)(rope + ((size_t)pos * 32 + (c >> 1) + 2) * 2);
                        f32x4 o0, o1;
                        o0[0] = v0[0] * cs0[0] - v0[1] * cs0[1]; o0[1] = v0[1] * cs0[0] + v0[0] * cs0[1]; o0[2] = v0[2] * cs0[2] - v0[3] * cs0[3]; o0[3] = v0[3] * cs0[2] + v0[2] * cs0[3];
                        o1[0] = v1[0] * cs1[0] - v1[1] * cs1[1]; o1[1] = v1[1] * cs1[0] + v1[0] * cs1[1]; o1[2] = v1[2] * cs1[2] - v1[3] * cs1[3]; o1[3] = v1[3] * cs1[2] + v1[2] * cs1[3];
                        *(u32x4*)(KR + (size_t)row * 64 + c) = pack8(o0, o1); } asm volatile("" ::: "memory"); }
        }
    }
};
struct EpiKvUp {
    static constexpr bool PERM = true, AFTER_DRAIN = false;
    bf16_t* KN; bf16_t* VV; const float* stats;
    __device__ __forceinline__ void operator()(const f32x4 (&acc)[2][2][4][2], const Unit& u, int wr, int wc, int fr, int fq) const {
#pragma unroll
        for (int ai = 0; ai < 2; ++ai)
#pragma unroll
            for (int m = 0; m < 4; ++m) { const int row = u.pm * BM + ai * HALF + wr * 64 + m * 16 + fr;
                const float rstd = 1.0f / sqrtf(stats[(size_t)row * 2] * (1.0f / 512.0f) + 1e-6f);
#pragma unroll
                for (int bj = 0; bj < 2; ++bj) { bf16_t* base = bj ? VV : KN; const int c = wc * 32 + 8 * fq;
                    *(u32x4*)(base + ((size_t)((row >> 11) * 16 + u.pn) * 2048 + (row & 2047)) * 128 + c) = pack8(acc[ai][bj][m][0] * rstd, acc[ai][bj][m][1] * rstd); } asm volatile("" ::: "memory"); }
    }
};
struct EpiQUp {
    static constexpr bool PERM = true, AFTER_DRAIN = false;
    bf16_t* Q; const float* stats; const float* rope; float qscale;
    __device__ __forceinline__ void operator()(const f32x4 (&acc)[2][2][4][2], const Unit& u, int wr, int wc, int fr, int fq) const {
#pragma unroll
        for (int ai = 0; ai < 2; ++ai)
#pragma unroll
            for (int m = 0; m < 4; ++m) { const int row = u.pm * BM + ai * HALF + wr * 64 + m * 16 + fr; const int pos = row & 2047;
                const float rs = qscale / sqrtf(stats[(size_t)row * 2 + 1] * (1.0f / 512.0f) + 1e-6f);
#pragma unroll
                for (int bj = 0; bj < 2; ++bj) { const int col0 = u.pn * BM + bj * HALF + wc * 32 + 8 * fq; const int j = col0 % 192;
                    f32x4 v0 = acc[ai][bj][m][0] * rs, v1 = acc[ai][bj][m][1] * rs;
                    if (j >= 128) { const int i0 = (j - 128) >> 1; const f32x4 cs0 = *(const f32x4*)(rope + ((size_t)pos * 32 + i0) * 2), cs1 = *(const f32x4*)(rope + ((size_t)pos * 32 + i0 + 2) * 2);
                        f32x4 o0, o1;
                        o0[0] = v0[0] * cs0[0] - v0[1] * cs0[1]; o0[1] = v0[1] * cs0[0] + v0[0] * cs0[1]; o0[2] = v0[2] * cs0[2] - v0[3] * cs0[3]; o0[3] = v0[3] * cs0[2] + v0[2] * cs0[3];
                        o1[0] = v1[0] * cs1[0] - v1[1] * cs1[1]; o1[1] = v1[1] * cs1[0] + v1[0] * cs1[1]; o1[2] = v1[2] * cs1[2] - v1[3] * cs1[3]; o1[3] = v1[3] * cs1[2] + v1[2] * cs1[3];
                        v0 = o0; v1 = o1; }
                    *(u32x4*)(Q + (size_t)row * 3072 + col0) = pack8(v0, v1); } asm volatile("" ::: "memory"); }
    }
};
template <class Epi, class Sched, bool ALIGN_EPI = false, bool SP2 = false>
__device__ __forceinline__ void gemm_phase(PG8_LAS unsigned char* lds, const Gemm g, const Sched& S, const Epi& E) {
    int tid_ = threadIdx.x; asm volatile("" : "+v"(tid_));
    const int tid = tid_, wid = __builtin_amdgcn_readfirstlane(tid >> 6), lane = tid & 63, wr = wid >> 2, wc = wid & 3, fr = lane & 15, fq = lane >> 4;
    const int K = g.K, nt = K / BK;
    unsigned voffA[2], voffB[2];
#pragma unroll
    for (int i = 0; i < 2; ++i) { int R, C; stage_rc(tid * 16 + i * 8192, R, C); const int Rb = Epi::PERM ? ((R & ~31) + perm32(R & 31)) : R;
        voffA[i] = (unsigned)(R * K + C) * 2u; voffB[i] = (unsigned)(Rb * K + C) * 2u; }
    const size_t kstep = (size_t)(BK * 2);
    const size_t hstep = (size_t)HALF * K * 2;
    const size_t tstep = 2 * hstep;
    const unsigned ldsw = (unsigned)wid * 1024u;
    const int aoff = lds_byte(wr * 64 + fr, fq * 8), boff = lds_byte(wc * 32 + fr, fq * 8);
#define PG8_SA(b, h) (((b) * 2 + (h)) * HTB)
#define PG8_SB(b, h) ((4 + (b) * 2 + (h)) * HTB)
#define PG8_STAGE(bufoff, gbase, voff) do { _Pragma("unroll") for (int _i = 0; _i < 2; ++_i) \
        __builtin_amdgcn_global_load_lds((const unsigned*)((const char*)(gbase) + (voff)[_i]), (PG8_LAS unsigned*)(lds + (bufoff) + ldsw + _i * 8192), 16, 0, 0); } while (0)
#define PG8_LDA(dst, b, h) do { _Pragma("unroll") for (int m = 0; m < 4; ++m) _Pragma("unroll") for (int k = 0; k < 2; ++k) dst[m][k] = *(const PG8_LAS bf16x8*)(lds + PG8_SA(b, h) + aoff + m * 2048 + k * 1024); } while (0)
#define PG8_LDB(dst, b, h) do { _Pragma("unroll") for (int n = 0; n < 2; ++n) _Pragma("unroll") for (int k = 0; k < 2; ++k) dst[n][k] = *(const PG8_LAS bf16x8*)(lds + PG8_SB(b, h) + boff + n * 2048 + k * 1024); } while (0)
#define PG8_MMA(ai, bj, At, Bt) do { __builtin_amdgcn_s_setprio(1); _Pragma("unroll") for (int m = 0; m < 4; ++m) _Pragma("unroll") for (int n = 0; n < 2; ++n) _Pragma("unroll") for (int k = 0; k < 2; ++k) \
        acc[ai][bj][m][n] = __builtin_amdgcn_mfma_f32_16x16x32_bf16(Bt[n][k], At[m][k], acc[ai][bj][m][n], 0, 0, 0); __builtin_amdgcn_s_setprio(0); } while (0)
#define PG8_WAIT_V(n) asm volatile("s_waitcnt vmcnt(" #n ")" ::: "memory")
#define PG8_WAIT_L(n) asm volatile("s_waitcnt lgkmcnt(" #n ")" ::: "memory")
#define PG8_BAR __builtin_amdgcn_s_barrier()
#define PG8_SCHED __builtin_amdgcn_sched_barrier(0)
    Unit cur, nxt; int ui = 0;
    if (!S.next(0, cur)) return;
    f32x4 acc[2][2][4][2];
#pragma unroll
    for (int a = 0; a < 2; ++a)
#pragma unroll
        for (int b = 0; b < 2; ++b)
#pragma unroll
            for (int m = 0; m < 4; ++m)
#pragma unroll
                for (int n = 0; n < 2; ++n) acc[a][b][m][n] = (f32x4){0.f, 0.f, 0.f, 0.f};
    bf16x8 At[4][2], B0[2][2], B1[2][2];
    const char* cA = (const char*)g.A + (size_t)cur.pm * tstep; const char* cB = (const char*)g.Bt + (size_t)cur.pn * tstep;
    S.a_ready(cur);
    if constexpr (SP2) {
        PG8_STAGE(PG8_SB(0, 0), cB, voffB); PG8_STAGE(PG8_SB(0, 1), cB + hstep, voffB); PG8_STAGE(PG8_SA(0, 0), cA, voffA); PG8_STAGE(PG8_SA(0, 1), cA + hstep, voffA);
        if (wr == 1) PG8_BAR;
        PG8_WAIT_V(2); PG8_BAR;
        PG8_STAGE(PG8_SB(1, 0), cB + kstep, voffB); PG8_STAGE(PG8_SA(1, 0), cA + kstep, voffA); PG8_STAGE(PG8_SB(1, 1), cB + hstep + kstep, voffB);
        PG8_WAIT_V(6); PG8_BAR;
    } else {
        PG8_STAGE(PG8_SB(0, 0), cB, voffB); PG8_STAGE(PG8_SA(0, 0), cA, voffA); PG8_STAGE(PG8_SB(0, 1), cB + hstep, voffB); PG8_STAGE(PG8_SA(0, 1), cA + hstep, voffA);
        if (wr == 1) PG8_BAR;
        PG8_WAIT_V(4); PG8_BAR;
        PG8_STAGE(PG8_SB(1, 0), cB + kstep, voffB); PG8_STAGE(PG8_SA(1, 0), cA + kstep, voffA); PG8_STAGE(PG8_SB(1, 1), cB + hstep + kstep, voffB);
        PG8_WAIT_V(6); PG8_BAR;
    }
    for (;;) {
        const bool has_next = S.next(ui + 1, nxt);
        const char* nA = has_next ? (const char*)g.A + (size_t)nxt.pm * tstep : cA; const char* nB = has_next ? (const char*)g.Bt + (size_t)nxt.pn * tstep : cB;
        for (int t = 0; t < nt; t += 2) {
            const bool last = (t == nt - 2);
            const char* a1 = cA + (size_t)(t + 1) * kstep;
            const char* a2 = last ? nA : cA + (size_t)(t + 2) * kstep; const char* b2 = last ? nB : cB + (size_t)(t + 2) * kstep;
            const char* a3 = a2 + kstep; const char* b3 = b2 + kstep;
            if (last && has_next) S.a_ready(nxt);
            if constexpr (SP2) {
            PG8_LDB(B0, 0, 0); PG8_LDB(B1, 0, 1); PG8_SCHED; PG8_LDA(At, 0, 0); PG8_STAGE(PG8_SA(1, 1), a1 + hstep, voffA);
            PG8_WAIT_V(8); PG8_WAIT_L(0); PG8_BAR; PG8_MMA(0, 0, At, B0); PG8_MMA(0, 1, At, B1); PG8_BAR; PG8_SCHED;
            PG8_LDA(At, 0, 1); PG8_STAGE(PG8_SB(0, 0), b2, voffB); PG8_STAGE(PG8_SB(0, 1), b2 + hstep, voffB); PG8_STAGE(PG8_SA(0, 0), a2, voffA);
            PG8_WAIT_V(8); PG8_WAIT_L(0); PG8_BAR; PG8_MMA(1, 0, At, B0); PG8_MMA(1, 1, At, B1); PG8_BAR; PG8_SCHED;
            PG8_LDB(B0, 1, 0); PG8_LDB(B1, 1, 1); PG8_SCHED; PG8_LDA(At, 1, 0); PG8_STAGE(PG8_SA(0, 1), a2 + hstep, voffA);
            PG8_WAIT_V(8); PG8_WAIT_L(0); PG8_BAR; PG8_MMA(0, 0, At, B0); PG8_MMA(0, 1, At, B1); PG8_BAR; PG8_SCHED;
            PG8_LDA(At, 1, 1); PG8_STAGE(PG8_SB(1, 0), b3, voffB); PG8_STAGE(PG8_SB(1, 1), b3 + hstep, voffB); PG8_STAGE(PG8_SA(1, 0), a3, voffA);
            PG8_WAIT_V(8); PG8_WAIT_L(0); PG8_BAR; PG8_MMA(1, 0, At, B0); PG8_MMA(1, 1, At, B1); PG8_BAR; PG8_SCHED;
            } else {
            PG8_LDB(B0, 0, 0); PG8_SCHED; PG8_LDA(At, 0, 0); PG8_STAGE(PG8_SA(1, 1), a1 + hstep, voffA);
            PG8_WAIT_L(8); PG8_BAR; PG8_WAIT_L(0); PG8_MMA(0, 0, At, B0); PG8_BAR; PG8_SCHED;
            PG8_LDB(B1, 0, 1); PG8_STAGE(PG8_SB(0, 0), b2, voffB);
            PG8_BAR; PG8_WAIT_L(0); PG8_MMA(0, 1, At, B1); PG8_BAR;
            PG8_LDA(At, 0, 1); PG8_STAGE(PG8_SA(0, 0), a2, voffA);
            PG8_BAR; PG8_WAIT_L(0); PG8_MMA(1, 0, At, B0); PG8_BAR; PG8_SCHED;
            PG8_STAGE(PG8_SB(0, 1), b2 + hstep, voffB);
            PG8_WAIT_V(6); PG8_BAR; PG8_MMA(1, 1, At, B1); PG8_BAR;
            PG8_LDB(B0, 1, 0); PG8_SCHED; PG8_LDA(At, 1, 0); PG8_STAGE(PG8_SA(0, 1), a2 + hstep, voffA);
            PG8_WAIT_L(8); PG8_BAR; PG8_WAIT_L(0); PG8_MMA(0, 0, At, B0); PG8_BAR; PG8_SCHED;
            PG8_LDB(B1, 1, 1); PG8_STAGE(PG8_SB(1, 0), b3, voffB);
            PG8_BAR; PG8_WAIT_L(0); PG8_MMA(0, 1, At, B1); PG8_BAR;
            PG8_LDA(At, 1, 1); PG8_STAGE(PG8_SA(1, 0), a3, voffA);
            PG8_BAR; PG8_WAIT_L(0); PG8_MMA(1, 0, At, B0); PG8_BAR; PG8_SCHED;
            PG8_STAGE(PG8_SB(1, 1), b3 + hstep, voffB);
            PG8_WAIT_V(6); PG8_BAR; PG8_MMA(1, 1, At, B1); PG8_BAR;
            }
        }
        if constexpr (ALIGN_EPI) { if (wr == 0) PG8_BAR; }
        if constexpr (!Epi::AFTER_DRAIN) { E(acc, cur, wr, wc, fr, fq); S.done(cur); }
        if (!has_next) break;
#pragma unroll
        for (int a = 0; a < 2; ++a)
#pragma unroll
            for (int b = 0; b < 2; ++b)
#pragma unroll
                for (int m = 0; m < 4; ++m)
#pragma unroll
                    for (int n = 0; n < 2; ++n) acc[a][b][m][n] = (f32x4){0.f, 0.f, 0.f, 0.f};
        cur = nxt; cA = nA; cB = nB; ++ui;
        if constexpr (ALIGN_EPI) { if (wr == 1) PG8_BAR; }
    }
    PG8_WAIT_V(0);
    if constexpr (!ALIGN_EPI) { if (wr == 0) PG8_BAR; }
    PG8_BAR;
    if constexpr (Epi::AFTER_DRAIN) { E.fused(acc, cur, wr, wc, fr, fq, lds, wid, lane); S.done(cur); }
#undef PG8_SA
#undef PG8_SB
#undef PG8_STAGE
#undef PG8_LDA
#undef PG8_LDB
#undef PG8_MMA
#undef PG8_WAIT_V
#undef PG8_WAIT_L
#undef PG8_BAR
#undef PG8_SCHED
}
}
using pg8::bf16_t; using pg8::bf16x8; using pg8::f32x4; using pg8::u32x4; using pg8::u32x2; using pg8::cvt_pk_bf16; using pg8::bf_lo; using pg8::bf_hi;
typedef short s16x4 __attribute__((ext_vector_type(4)));
#define LAS __attribute__((address_space(3)))

constexpr int NB = 8, SEQ = 2048, DM = 2048, TOK = NB * SEQ, DFF = 8192;
constexpr int NWAVES = 8, NTHR = 512;
constexpr float DN_ALPHA = 1.4142135623730951f;
constexpr size_t MiB = 1u << 20;
constexpr size_t WS_ROPE = 0;
constexpr size_t WS_CTL2 = 507 * MiB;
constexpr size_t WS_BAR = WS_CTL2;
constexpr size_t WS_UC = WS_CTL2 + 16384;
constexpr int UC_U1 = 0, UC_C1 = 8192, UC_U2 = 16384, UC_C2 = 16384 + 1280, UC_U3 = 16384 + 2560, UC_C3 = 16384 + 2560 + 8192;
constexpr size_t WS_LNST = WS_CTL2 + 256 * 1024;
constexpr size_t WS_RMS = WS_CTL2 + 768 * 1024;
constexpr size_t WS_STATS = 1 * MiB;
constexpr size_t WS_GATESP = 2 * MiB;
constexpr size_t WS_W_IN = 7 * MiB;
constexpr size_t WS_W_AOUT = 31 * MiB;
constexpr size_t WS_W1_0 = 39 * MiB;
constexpr size_t WS_W2_0 = 71 * MiB;
constexpr size_t WS_W_DN = 103 * MiB;
constexpr size_t WS_W_KVUP = 108 * MiB;
constexpr size_t WS_W_QUP = 112 * MiB;
constexpr size_t WS_W_BOUT = 115 * MiB;
constexpr size_t WS_W1_1 = 123 * MiB;
constexpr size_t WS_W2_1 = 155 * MiB;
constexpr size_t WS_XA = 187 * MiB;
constexpr size_t WS_BIG = 251 * MiB;
constexpr size_t WS_XB = WS_BIG, WS_QK = WS_BIG + 64 * MiB, WS_V = WS_BIG + 128 * MiB, WS_O = WS_BIG + 192 * MiB;
constexpr size_t WS_KR = WS_BIG, WS_KN = WS_BIG + 2 * MiB, WS_VV = WS_BIG + 66 * MiB, WS_C = WS_BIG + 130 * MiB, WS_QL = WS_BIG + 146 * MiB, WS_AO = WS_BIG + 162 * MiB;
constexpr size_t WS_END = 508 * MiB;
constexpr int LDS_BYTES = 147456, LDS_MISC = 131072 + 512;

struct Params { const float* in[20]; float* out; unsigned char* ws; };
enum { I_X = 0, I_AWIN, I_ABG, I_ACW, I_ACB, I_ANW, I_AWOUT, I_KVWD, I_KVNW, I_KVWU, I_BWDQ, I_BQNW, I_BWUQ, I_BWOUT, I_W1, I_W2, I_L1G, I_L1B, I_L2G, I_L2B };

__device__ __forceinline__ unsigned f2bf(float f) { unsigned u = __builtin_bit_cast(unsigned, f); return (u + 0x7fffu + ((u >> 16) & 1u)) >> 16; }
__device__ __forceinline__ float bf2f(unsigned short h) { return __uint_as_float((unsigned)h << 16); }
__device__ __forceinline__ float wave_sum(float v) {
#pragma unroll
    for (int o = 1; o < 64; o <<= 1) v += __shfl_xor(v, o);
    return v;
}
__device__ __forceinline__ float wave_max(float v) {
#pragma unroll
    for (int o = 1; o < 64; o <<= 1) v = fmaxf(v, __shfl_xor(v, o));
    return v;
}
#define MFMA16(a, b, c) __builtin_amdgcn_mfma_f32_16x16x32_bf16((a), (b), (c), 0, 0, 0)

__device__ __forceinline__ int srccol(int mode, int n) {
    if (mode == 1) return 512 + ((n & 1) ? 32 + (n >> 1) : (n >> 1));
    if (mode == 2) { const int h = n / 192, j = n % 192; if (j < 128) return n; const int r = j - 128; return h * 192 + 128 + ((r & 1) ? 32 + (r >> 1) : (r >> 1)); }
    return n;
}
__device__ __forceinline__ float bf16_round(float x) { return __uint_as_float(f2bf(x) << 16); }
__device__ __forceinline__ void tr_item(const float* W, int ldw, int K, bf16_t* WT, int nblk, const float* kscale, int mode, float* scr, int item, int lane, float* uacc, float* cacc, const float* lnb) {
    const int kb = item / nblk, nb = item % nblk, k0 = 64 * kb, n0 = 32 * nb;
    const int sc = srccol(mode, n0 + (lane & 31));
    float us = 0.f, cs = 0.f;
#pragma unroll 8
    for (int i = 0; i < 32; ++i) { const int kk = 2 * i + (lane >> 5); const float w0 = W[(size_t)(k0 + kk) * ldw + sc]; float w = w0; if (kscale) w *= kscale[k0 + kk]; scr[kk * 33 + (lane & 31)] = w;
        if (uacc) { us += bf16_round(w); cs += lnb[k0 + kk] * w0; } }
    if (uacc) { us += __shfl_xor(us, 32); cs += __shfl_xor(cs, 32); if (lane < 32) { __hip_atomic_fetch_add(uacc + n0 + lane, us, __ATOMIC_RELAXED, __HIP_MEMORY_SCOPE_AGENT); __hip_atomic_fetch_add(cacc + n0 + lane, cs, __ATOMIC_RELAXED, __HIP_MEMORY_SCOPE_AGENT); } }
    asm volatile("s_waitcnt lgkmcnt(0)" ::: "memory"); asm volatile("" ::: "memory");
    const int c = lane & 7;
#pragma unroll
    for (int j = 0; j < 4; ++j) { const int n = (lane >> 3) + 8 * j; const float* s = scr + (8 * c) * 33 + n;
        u32x4 o; o.x = cvt_pk_bf16(s[0 * 33], s[1 * 33]); o.y = cvt_pk_bf16(s[2 * 33], s[3 * 33]); o.z = cvt_pk_bf16(s[4 * 33], s[5 * 33]); o.w = cvt_pk_bf16(s[6 * 33], s[7 * 33]);
        *(u32x4*)(WT + (size_t)(n0 + n) * K + k0 + 8 * c) = o; }
    asm volatile("s_waitcnt lgkmcnt(0)" ::: "memory"); asm volatile("" ::: "memory");
}
struct TrJob { const float* W; int ldw, K, nblk, r; bf16_t* WT; const float* ksc; float* ua; float* ca; const float* lb; };
__device__ __forceinline__ void tr64_load(const TrJob& j, f32x4 (&v)[16], int lane) {
    const int kb = j.r / j.nblk, nb = j.r % j.nblk, k0 = 64 * kb, n0 = 64 * nb, n4 = (lane & 15) * 4, kr = lane >> 4;
#pragma unroll
    for (int i = 0; i < 16; ++i) v[i] = *(const f32x4*)(j.W + (size_t)(k0 + kr + 4 * i) * j.ldw + n0 + n4);
}
__device__ __forceinline__ void tr64_process(const TrJob& j, const f32x4 (&v)[16], float* scr, int lane) {
    asm volatile("" : "+v"(lane));
    const int kb = j.r / j.nblk, nb = j.r % j.nblk, k0 = 64 * kb, n0 = 64 * nb, K = j.K;
    const int n4 = (lane & 15) * 4, kr = lane >> 4;
    const float* kscale = j.ksc; float* uacc = j.ua; float* cacc = j.ca; const float* lnb = j.lb; bf16_t* WT = j.WT;
    float us[4] = {0.f, 0.f, 0.f, 0.f}, cs[4] = {0.f, 0.f, 0.f, 0.f};
#pragma unroll
    for (int i = 0; i < 16; ++i) { const int kk = kr + 4 * i; const float s = kscale ? kscale[k0 + kk] : 1.0f; const float bb = uacc ? lnb[k0 + kk] : 0.f;
#pragma unroll
        for (int e = 0; e < 4; ++e) { const float xw = v[i][e] * s; scr[kk * 64 + ((n4 + e + kk) & 63)] = xw; us[e] += bf16_round(xw); cs[e] += bb * v[i][e]; } }
    if (uacc) {
#pragma unroll
        for (int e = 0; e < 4; ++e) { us[e] += __shfl_xor(us[e], 16); us[e] += __shfl_xor(us[e], 32); cs[e] += __shfl_xor(cs[e], 16); cs[e] += __shfl_xor(cs[e], 32); }
        if (lane < 16) {
#pragma unroll
            for (int e = 0; e < 4; ++e) { __hip_atomic_fetch_add(uacc + n0 + n4 + e, us[e], __ATOMIC_RELAXED, __HIP_MEMORY_SCOPE_AGENT); __hip_atomic_fetch_add(cacc + n0 + n4 + e, cs[e], __ATOMIC_RELAXED, __HIP_MEMORY_SCOPE_AGENT); } } }
    asm volatile("s_waitcnt lgkmcnt(0)" ::: "memory");
    const int c = lane & 7;
#pragma unroll
    for (int jj = 0; jj < 8; ++jj) { const int n = (lane >> 3) + 8 * jj; float r[8];
#pragma unroll
        for (int e = 0; e < 8; ++e) r[e] = scr[(8 * c + e) * 64 + ((n + 8 * c + e) & 63)];
        u32x4 o; o.x = cvt_pk_bf16(r[0], r[1]); o.y = cvt_pk_bf16(r[2], r[3]); o.z = cvt_pk_bf16(r[4], r[5]); o.w = cvt_pk_bf16(r[6], r[7]);
        *(u32x4*)(WT + (size_t)(n0 + n) * K + k0 + 8 * c) = o; }
    asm volatile("s_waitcnt lgkmcnt(0)" ::: "memory");
}
__device__ __forceinline__ void p0_prologue(const Params& p, unsigned char* lds) {
    int tid_ = threadIdx.x; asm volatile("" : "+v"(tid_)); const int tid = tid_, lane = tid & 63, wave = tid >> 6;
    const int gw = blockIdx.x * NWAVES + wave, NGW = gridDim.x * NWAVES;
    unsigned char* ws = p.ws;
    float* scr = (float*)(lds + wave * 16384);
    float* UC = (float*)(ws + WS_UC);
    constexpr int J0 = 32 * 96, J1 = 32 * 32, J2 = 32 * 128, J3 = 128 * 32, J4 = 32 * 8, J5 = 32 * 8, J7 = 8 * 64, J9 = 32 * 32, J10 = J2, J11 = J3;
    constexpr int NWIDE = J0 + J1 + J2 + J3 + J4 + J5 + J7 + J9 + J10 + J11;
#define TR_DECODE(job, it_) do { int r = (it_); job.ksc = nullptr; job.ua = nullptr; job.ca = nullptr; job.lb = nullptr; \
        if (r < J0) { job.W = p.in[I_AWIN]; job.ldw = 6160; job.K = 2048; job.WT = (bf16_t*)(ws + WS_W_IN); job.nblk = 96; } \
        else if ((r -= J0) < J1) { job.W = p.in[I_AWOUT]; job.ldw = 2048; job.K = 2048; job.WT = (bf16_t*)(ws + WS_W_AOUT); job.nblk = 32; } \
        else if ((r -= J1) < J2) { job.W = p.in[I_W1]; job.ldw = 8192; job.K = 2048; job.WT = (bf16_t*)(ws + WS_W1_0); job.nblk = 128; job.ksc = p.in[I_L1G]; job.lb = p.in[I_L1B]; job.ua = UC + UC_U1; job.ca = UC + UC_C1; } \
        else if ((r -= J2) < J3) { job.W = p.in[I_W2]; job.ldw = 2048; job.K = 8192; job.WT = (bf16_t*)(ws + WS_W2_0); job.nblk = 32; } \
        else if ((r -= J3) < J4) { job.W = p.in[I_KVWD]; job.ldw = 576; job.K = 2048; job.WT = (bf16_t*)(ws + WS_W_DN); job.nblk = 8; job.ksc = p.in[I_L2G]; job.lb = p.in[I_L2B]; job.ua = UC + UC_U2; job.ca = UC + UC_C2; } \
        else if ((r -= J4) < J5) { job.W = p.in[I_BWDQ]; job.ldw = 512; job.K = 2048; job.WT = (bf16_t*)(ws + WS_W_DN) + (size_t)512 * 2048; job.nblk = 8; job.ksc = p.in[I_L2G]; job.lb = p.in[I_L2B]; job.ua = UC + UC_U2 + 512; job.ca = UC + UC_C2 + 512; } \
        else if ((r -= J5) < J7) { job.W = p.in[I_KVWU]; job.ldw = 4096; job.K = 512; job.WT = (bf16_t*)(ws + WS_W_KVUP); job.nblk = 64; job.ksc = p.in[I_KVNW]; } \
        else if ((r -= J7) < J9) { job.W = p.in[I_BWOUT]; job.ldw = 2048; job.K = 2048; job.WT = (bf16_t*)(ws + WS_W_BOUT); job.nblk = 32; } \
        else if ((r -= J9) < J10) { job.W = p.in[I_W1] + (size_t)2048 * 8192; job.ldw = 8192; job.K = 2048; job.WT = (bf16_t*)(ws + WS_W1_1); job.nblk = 128; job.ksc = p.in[I_L1G] + 2048; job.lb = p.in[I_L1B] + 2048; job.ua = UC + UC_U3; job.ca = UC + UC_C3; } \
        else { r -= J10; job.W = p.in[I_W2] + (size_t)8192 * 2048; job.ldw = 2048; job.K = 8192; job.WT = (bf16_t*)(ws + WS_W2_1); job.nblk = 32; } \
        job.r = r; } while (0)
    if (gw < NWIDE) {
        TrJob cur; TR_DECODE(cur, gw); f32x4 vc[16]; tr64_load(cur, vc, lane);
        for (int it = gw; it < NWIDE; it += NGW) {
            const int nx = it + NGW; TrJob nxt = cur; f32x4 vn[16];
            if (nx < NWIDE) { TR_DECODE(nxt, nx); tr64_load(nxt, vn, lane); }
            tr64_process(cur, vc, scr, lane);
            if (nx < NWIDE) { cur = nxt;
#pragma unroll
                for (int i = 0; i < 16; ++i) vc[i] = vn[i]; }
        }
    }
#undef TR_DECODE
    { constexpr int J6 = 32 * 2, J8 = 8 * 96;
      for (int it = gw; it < J6 + J8; it += NGW) {
          if (it < J6) tr_item(p.in[I_KVWD], 576, 2048, (bf16_t*)(ws + WS_W_DN) + (size_t)1024 * 2048, 2, p.in[I_L2G], 1, scr, it, lane, UC + UC_U2 + 1024, UC + UC_C2 + 1024, p.in[I_L2B]);
          else tr_item(p.in[I_BWUQ], 3072, 512, (bf16_t*)(ws + WS_W_QUP), 96, p.in[I_BQNW], 2, scr, it - J6, lane, nullptr, nullptr, nullptr); } }
    { u32x4* z = (u32x4*)((bf16_t*)(ws + WS_W_DN) + (size_t)1088 * 2048); const int n16 = 192 * 2048 * 2 / 16;
      for (int i = blockIdx.x * NTHR + tid; i < n16; i += gridDim.x * NTHR) z[i] = (u32x4){0u, 0u, 0u, 0u}; }
    { float* rope = (float*)(ws + WS_ROPE);
      for (int idx = blockIdx.x * NTHR + tid; idx < 2048 * 32; idx += gridDim.x * NTHR) {
          const int pos = idx >> 5, i = idx & 31;
          double f = 1.0; for (int k = 0; k < i; ++k) f *= 0.74989420933245582730;
          const double ang = (double)pos * f;
          const double n = __builtin_rint(ang * 0.15915494309189533577);
          double r = __builtin_fma(-n, 6.283185307179586232, ang); r = __builtin_fma(-n, 2.449293598294706414e-16, r);
          const double qd = __builtin_rint(r * 0.63661977236758134308); const int qi = (int)qd;
          double t = __builtin_fma(-qd, 1.5707963267948965580, r); t = __builtin_fma(-qd, 6.123233995736766036e-17, t);
          const double t2 = t * t;
          double sp = -1.0 / 1307674368000.0; sp = sp * t2 + 1.0 / 6227020800.0; sp = sp * t2 - 1.0 / 39916800.0; sp = sp * t2 + 1.0 / 362880.0; sp = sp * t2 - 1.0 / 5040.0; sp = sp * t2 + 1.0 / 120.0; sp = sp * t2 - 1.0 / 6.0; sp = sp * t2 + 1.0;
          const double st = sp * t;
          double cp = 1.0 / 20922789888000.0; cp = cp * t2 - 1.0 / 87178291200.0; cp = cp * t2 + 1.0 / 479001600.0; cp = cp * t2 - 1.0 / 3628800.0; cp = cp * t2 + 1.0 / 40320.0; cp = cp * t2 - 1.0 / 720.0; cp = cp * t2 + 1.0 / 24.0; cp = cp * t2 - 0.5; cp = cp * t2 + 1.0;
          const int qm = qi & 3; double sv, cv;
          if (qm == 0) { sv = st; cv = cp; } else if (qm == 1) { sv = cp; cv = -st; } else if (qm == 2) { sv = -st; cv = -cp; } else { sv = -cp; cv = st; }
          rope[idx * 2] = (float)cv; rope[idx * 2 + 1] = (float)sv; } }
    { const float* x = p.in[I_X]; const float* win = p.in[I_AWIN]; bf16_t* XB = (bf16_t*)(ws + WS_XB); float* GP = (float*)(ws + WS_GATESP);
      const int fr = lane & 15, fq = lane >> 4;
      bf16_t* wgT = (bf16_t*)lds; constexpr int WGS = 2056;
      __syncthreads();
      for (int i = tid; i < 2048 * 4; i += NTHR) { const int k = i >> 2, g4 = (i & 3) * 4; const f32x4 wq = *(const f32x4*)(win + (size_t)k * 6160 + 6144 + g4);
          const unsigned u0 = cvt_pk_bf16(wq[0], wq[1]), u1 = cvt_pk_bf16(wq[2], wq[3]);
          wgT[(g4 + 0) * WGS + k] = (bf16_t)u0; wgT[(g4 + 1) * WGS + k] = (bf16_t)(u0 >> 16); wgT[(g4 + 2) * WGS + k] = (bf16_t)u1; wgT[(g4 + 3) * WGS + k] = (bf16_t)(u1 >> 16); }
      __syncthreads();
      for (int task = gw; task < 4096; task += NGW) {
          const int g16 = task >> 2, kq = task & 3; const int row = g16 * 16 + fr;
          f32x4 acc = {0.f, 0.f, 0.f, 0.f};
          const float* xp = x + (size_t)row * 2048 + kq * 512 + 8 * fq; bf16_t* xo = XB + (size_t)row * 2048 + kq * 512 + 8 * fq; const bf16_t* wl = wgT + fr * WGS + kq * 512 + 8 * fq;
#pragma unroll 8
          for (int s = 0; s < 16; ++s) {
              const f32x4 a0 = *(const f32x4*)(xp + 32 * s), a1 = *(const f32x4*)(xp + 32 * s + 4);
              const u32x4 aw = pg8::pack8(a0, a1);
              *(u32x4*)(xo + 32 * s) = aw;
              acc = MFMA16(__builtin_bit_cast(bf16x8, aw), *(const bf16x8*)(wl + 32 * s), acc);
          }
#pragma unroll
          for (int i = 0; i < 4; ++i) GP[((size_t)kq * TOK + g16 * 16 + 4 * fq + i) * 16 + fr] = acc[i];
      } }
}
__device__ __forceinline__ float wave_scan_add(float v, int lane) {
#pragma unroll
    for (int o = 1; o < 64; o <<= 1) { const float t = __shfl_up(v, o); if (lane >= o) v += t; }
    return v;
}
__device__ __forceinline__ float wave_scan_max(float v, int lane) {
#pragma unroll
    for (int o = 1; o < 64; o <<= 1) { const float t = __shfl_up(v, o); if (lane >= o) v = fmaxf(v, t); }
    return v;
}
constexpr int GV_RT = 0, GV_CT = 131072, GV_WI = 262144, GV_EN = 393216, GV_WK = 524288, GV_DEC = 655360;
__device__ __forceinline__ void conv_phase(const Params& p) {
    int tid_ = threadIdx.x; asm volatile("" : "+v"(tid_)); const int tid = tid_, lane = tid & 63, wave = tid >> 6;
    { const int gwave = blockIdx.x * NWAVES + wave;
      if ((gwave & 31) == 0) { const int bh = gwave >> 5, b = bh >> 3, h = bh & 7;
          const float* GP = (const float*)(p.ws + WS_GATESP); const float* bg = p.in[I_ABG]; float* GV = (float*)p.out;
          const float bi = bg[h], bf = bg[8 + h]; float m_old = 0.f;
          for (int cb = 0; cb < 32; cb += 8) {
              float ivs[8], fps[8];
#pragma unroll
              for (int j = 0; j < 8; ++j) { const size_t gr = ((size_t)b * SEQ + (cb + j) * 64 + lane) * 16; float iv = bi, fp = bf;
#pragma unroll
                  for (int q = 0; q < 4; ++q) { iv += GP[(size_t)q * TOK * 16 + gr + h]; fp += GP[(size_t)q * TOK * 16 + gr + 8 + h]; }
                  ivs[j] = iv; fps[j] = fp; }
#pragma unroll
              for (int j = 0; j < 8; ++j) { const int c = cb + j, tk = c * 64 + lane; const float iv = ivs[j], fp = fps[j];
                  const float logf = fminf(fp, 0.f) - __logf(1.0f + __expf(-fabsf(fp)));
                  const float bcum = wave_scan_add(logf, lane);
                  const float g = __shfl(bcum, 63);
                  const float ct = iv - bcum;
                  const float pm = wave_scan_max(ct, lane);
                  const float cmax = __shfl(pm, 63);
                  const float mt = fmaxf(bcum + pm, bcum + m_old);
                  const float rt = bcum - mt;
                  const float mnew = g + fmaxf(m_old, cmax);
                  const size_t o = (size_t)bh * 2048 + tk;
                  GV[GV_RT + o] = rt; GV[GV_CT + o] = ct; GV[GV_WI + o] = __expf(rt + m_old); GV[GV_EN + o] = __expf(-mt); GV[GV_WK + o] = __expf(g + ct - mnew);
                  if (lane == 0) GV[GV_DEC + bh * 32 + c] = __expf(g + m_old - mnew);
                  m_old = mnew; } } } }
    const bf16_t* QK = (const bf16_t*)(p.ws + WS_QK); bf16_t* QKc = (bf16_t*)(p.ws + WS_XB);
    const float* convw = p.in[I_ACW]; const float* convb = p.in[I_ACB];
    for (int idx = blockIdx.x * NTHR + tid; idx < TOK * 256; idx += gridDim.x * NTHR) {
        const int tok = idx >> 8, ch = (idx & 255) * 8, spos = tok & 2047;
        const f32x4 b0 = *(const f32x4*)(convb + ch), b1 = *(const f32x4*)(convb + ch + 4);
        float a8[8] = {b0[0], b0[1], b0[2], b0[3], b1[0], b1[1], b1[2], b1[3]};
#pragma unroll
        for (int j = 0; j < 4; ++j) {
            if (spos - 3 + j >= 0) { const u32x4 raw = *(const u32x4*)(QK + (size_t)(tok - 3 + j) * 2048 + ch);
                const f32x4 w0 = *(const f32x4*)(convw + j * 2048 + ch), w1 = *(const f32x4*)(convw + j * 2048 + ch + 4);
                a8[0] += bf_lo(raw.x) * w0[0]; a8[1] += bf_hi(raw.x) * w0[1]; a8[2] += bf_lo(raw.y) * w0[2]; a8[3] += bf_hi(raw.y) * w0[3];
                a8[4] += bf_lo(raw.z) * w1[0]; a8[5] += bf_hi(raw.z) * w1[1]; a8[6] += bf_lo(raw.w) * w1[2]; a8[7] += bf_hi(raw.w) * w1[3]; } }
        const float sc = (ch >= 1024) ? 1.0f : 0.08838834764831845f;
#pragma unroll
        for (int e = 0; e < 8; ++e) a8[e] = a8[e] / (1.0f + __expf(-a8[e])) * sc;
        u32x4 o; o.x = cvt_pk_bf16(a8[0], a8[1]); o.y = cvt_pk_bf16(a8[2], a8[3]); o.z = cvt_pk_bf16(a8[4], a8[5]); o.w = cvt_pk_bf16(a8[6], a8[7]);
        { const int isk = ch >> 10, hh = (ch & 1023) >> 7, cl = ch & 127;
          *(u32x4*)(QKc + ((size_t)(isk * 64 + (tok >> 11) * 8 + hh) * 2048 + spos) * 128 + cl) = o; }
    }
}
__device__ __forceinline__ void mlstm_phase(const Params& p, unsigned char* lds) {
    int tid_ = threadIdx.x; asm volatile("" : "+v"(tid_)); const int tid = tid_, lane = tid & 63, w = tid >> 6, fr = lane & 15, fq = lane >> 4;
    constexpr int QS = 144, VS = 80;
    bf16_t* q_s = (bf16_t*)lds;
    bf16_t* k_s = q_s + 64 * QS;
    bf16_t* vT = k_s + 64 * QS;
    bf16_t* kwT = vT + 80 * VS;
    bf16_t* CT_s = kwT + 128 * VS;
    const bf16_t* QKc = (const bf16_t*)(p.ws + WS_XB); const bf16_t* V = (const bf16_t*)(p.ws + WS_V); bf16_t* H = (bf16_t*)(p.ws + WS_XA);
    const float* GV = (const float*)p.out;
    { const int item = blockIdx.x;
        const int bh = item >> 2, sl = item & 3, b = bh >> 3, h = bh & 7;
        __syncthreads();
        for (int i = tid; i < 2 * 80 * QS; i += NTHR) CT_s[i] = 0;
        for (int i = tid; i < 16 * VS; i += NTHR) vT[64 * VS + i] = (i < VS) ? (bf16_t)0x3F80 : (bf16_t)0;
        f32x4 Cacc[5];
#pragma unroll
        for (int i = 0; i < 5; ++i) Cacc[i] = (f32x4){0.f, 0.f, 0.f, 0.f};
        const int t0 = tid >> 4, cg0 = tid & 15, sv = tid >> 3, vg = tid & 7, tt = w & 3, vt0 = (w < 4) ? 0 : 2;
        const bf16_t* qsrc = QKc + ((size_t)bh * 2048 + t0) * 128 + cg0 * 8;
        const bf16_t* vsrc = V + ((size_t)(bh * 4 + sl) * 2048 + sv) * 64 + vg * 8;
        const float* gvb = GV + (size_t)bh * 2048;
        u32x4 rq0, rq1, rk0, rk1, rv; float wk0, wk1, rt_t, wi_t, en_t, dec; f32x4 ctv[4];
#define ML_LOAD(c) do { const size_t o_ = (size_t)(c) * 64 * 128; rq0 = *(const u32x4*)(qsrc + o_); rq1 = *(const u32x4*)(qsrc + o_ + 32 * 128); rk0 = *(const u32x4*)(qsrc + o_ + (size_t)TOK * 1024); rk1 = *(const u32x4*)(qsrc + o_ + 32 * 128 + (size_t)TOK * 1024); \
            rv = *(const u32x4*)(vsrc + (size_t)(c) * 64 * 64); const float* g_ = gvb + (c) * 64; wk0 = g_[GV_WK + t0]; wk1 = g_[GV_WK + t0 + 32]; rt_t = g_[GV_RT + 16 * tt + fr]; wi_t = g_[GV_WI + 16 * tt + fr]; en_t = g_[GV_EN + 16 * tt + fr]; \
            dec = GV[GV_DEC + bh * 32 + (c)]; _Pragma("unroll") for (int st_ = 0; st_ < 4; ++st_) ctv[st_] = *(const f32x4*)(g_ + GV_CT + 16 * st_ + 4 * fq); } while (0)
#define ML_BAR() asm volatile("s_waitcnt lgkmcnt(0)\n\ts_barrier" ::: "memory")
        ML_LOAD(0);
        __syncthreads();
        for (int c = 0; c < 32; ++c) {
            const size_t rowc = (size_t)b * SEQ + c * 64;
            const bf16_t* Ccur = CT_s + (c & 1) * 80 * QS; bf16_t* Cnxt = CT_s + ((c + 1) & 1) * 80 * QS;
            *(u32x4*)(q_s + t0 * QS + cg0 * 8) = rq0; *(u32x4*)(q_s + (t0 + 32) * QS + cg0 * 8) = rq1;
            *(u32x4*)(k_s + t0 * QS + cg0 * 8) = rk0; *(u32x4*)(k_s + (t0 + 32) * QS + cg0 * 8) = rk1;
            { bf16_t* d = vT + (vg * 8) * VS + sv;
              d[0] = (bf16_t)rv.x; d[VS] = (bf16_t)(rv.x >> 16); d[2 * VS] = (bf16_t)rv.y; d[3 * VS] = (bf16_t)(rv.y >> 16);
              d[4 * VS] = (bf16_t)rv.z; d[5 * VS] = (bf16_t)(rv.z >> 16); d[6 * VS] = (bf16_t)rv.w; d[7 * VS] = (bf16_t)(rv.w >> 16); }
            { bf16_t* d = kwT + (cg0 * 8) * VS + t0; unsigned u_;
              u_ = cvt_pk_bf16(bf_lo(rk0.x) * wk0, bf_hi(rk0.x) * wk0); d[0] = (bf16_t)u_; d[VS] = (bf16_t)(u_ >> 16);
              u_ = cvt_pk_bf16(bf_lo(rk0.y) * wk0, bf_hi(rk0.y) * wk0); d[2 * VS] = (bf16_t)u_; d[3 * VS] = (bf16_t)(u_ >> 16);
              u_ = cvt_pk_bf16(bf_lo(rk0.z) * wk0, bf_hi(rk0.z) * wk0); d[4 * VS] = (bf16_t)u_; d[5 * VS] = (bf16_t)(u_ >> 16);
              u_ = cvt_pk_bf16(bf_lo(rk0.w) * wk0, bf_hi(rk0.w) * wk0); d[6 * VS] = (bf16_t)u_; d[7 * VS] = (bf16_t)(u_ >> 16);
              d += 32;
              u_ = cvt_pk_bf16(bf_lo(rk1.x) * wk1, bf_hi(rk1.x) * wk1); d[0] = (bf16_t)u_; d[VS] = (bf16_t)(u_ >> 16);
              u_ = cvt_pk_bf16(bf_lo(rk1.y) * wk1, bf_hi(rk1.y) * wk1); d[2 * VS] = (bf16_t)u_; d[3 * VS] = (bf16_t)(u_ >> 16);
              u_ = cvt_pk_bf16(bf_lo(rk1.z) * wk1, bf_hi(rk1.z) * wk1); d[4 * VS] = (bf16_t)u_; d[5 * VS] = (bf16_t)(u_ >> 16);
              u_ = cvt_pk_bf16(bf_lo(rk1.w) * wk1, bf_hi(rk1.w) * wk1); d[6 * VS] = (bf16_t)u_; d[7 * VS] = (bf16_t)(u_ >> 16); }
            const float rt_c = rt_t, wi_c = wi_t, en_c = en_t, dec_c = dec; f32x4 ct_c[4];
#pragma unroll
            for (int i = 0; i < 4; ++i) ct_c[i] = ctv[i];
            if (c + 1 < 32) ML_LOAD(c + 1);
            ML_BAR();
            bf16x8 qfr[4];
#pragma unroll
            for (int ks = 0; ks < 4; ++ks) qfr[ks] = *(const bf16x8*)(q_s + (16 * tt + fr) * QS + 32 * ks + 8 * fq);
            f32x4 P[4];
#pragma unroll
            for (int st = 0; st < 4; ++st) { f32x4 acc = {0.f, 0.f, 0.f, 0.f};
                if (st <= tt) {
#pragma unroll
                    for (int ks = 0; ks < 4; ++ks) { const bf16x8 A = *(const bf16x8*)(k_s + (16 * st + fr) * QS + 32 * ks + 8 * fq); acc = MFMA16(A, qfr[ks], acc); } }
                const int tq = 16 * tt + fr;
#pragma unroll
                for (int i = 0; i < 4; ++i) { const int s = 16 * st + 4 * fq + i; P[st][i] = (s <= tq) ? acc[i] * __expf(rt_c + ct_c[st][i]) : 0.f; } }
            bf16x8 pf[2];
            pf[0] = __builtin_bit_cast(bf16x8, pg8::pack8(P[0], P[1])); pf[1] = __builtin_bit_cast(bf16x8, pg8::pack8(P[2], P[3]));
            f32x4 num[3];
#pragma unroll
            for (int vi = 0; vi < 3; ++vi) { const int vt = (vi < 2) ? vt0 + vi : 4; f32x4 a1 = {0.f, 0.f, 0.f, 0.f}, a2 = {0.f, 0.f, 0.f, 0.f};
#pragma unroll
                for (int k2 = 0; k2 < 2; ++k2) { const s16x4 lo = *(const s16x4*)(vT + (16 * vt + fr) * VS + 32 * k2 + 4 * fq), hi = *(const s16x4*)(vT + (16 * vt + fr) * VS + 32 * k2 + 16 + 4 * fq);
                    const bf16x8 A = __builtin_shufflevector(lo, hi, 0, 1, 2, 3, 4, 5, 6, 7); a1 = MFMA16(A, pf[k2], a1); }
#pragma unroll
                for (int ks = 0; ks < 4; ++ks) { const bf16x8 A = *(const bf16x8*)(Ccur + (16 * vt + fr) * QS + 32 * ks + 8 * fq); a2 = MFMA16(A, qfr[ks], a2); }
                num[vi] = a1 + a2 * wi_c; }
            { const float den = __shfl(num[2][0], fr);
              const float rinv = 1.0f / fmaxf(fabsf(den), en_c);
#pragma unroll
              for (int vi = 0; vi < 2; ++vi) { u32x2 r; r.x = cvt_pk_bf16(num[vi][0] * rinv, num[vi][1] * rinv); r.y = cvt_pk_bf16(num[vi][2] * rinv, num[vi][3] * rinv);
                  *(u32x2*)(H + (rowc + 16 * tt + fr) * 2048 + h * 256 + sl * 64 + 16 * (vt0 + vi) + 4 * fq) = r; } }
#pragma unroll
            for (int vt = 0; vt < 5; ++vt) { f32x4 a = Cacc[vt] * dec_c;
#pragma unroll
                for (int ks = 0; ks < 2; ++ks) { const bf16x8 A = *(const bf16x8*)(vT + (16 * vt + fr) * VS + 32 * ks + 8 * fq), B = *(const bf16x8*)(kwT + (16 * w + fr) * VS + 32 * ks + 8 * fq); a = MFMA16(A, B, a); }
                Cacc[vt] = a;
#pragma unroll
                for (int i = 0; i < 0; ++i) {}
                { bf16_t* d = Cnxt + (16 * vt + 4 * fq) * QS + 16 * w + fr; const unsigned u0 = cvt_pk_bf16(a[0], a[1]), u1 = cvt_pk_bf16(a[2], a[3]);
                  d[0] = (bf16_t)u0; d[QS] = (bf16_t)(u0 >> 16); d[2 * QS] = (bf16_t)u1; d[3 * QS] = (bf16_t)(u1 >> 16); } }
            ML_BAR();
        }
#undef ML_LOAD
#undef ML_BAR
    }
}
__device__ __forceinline__ void gate_phase(const Params& p) {
    int tid_ = threadIdx.x; asm volatile("" : "+v"(tid_)); const int tid = tid_, lane = tid & 63, wave = tid >> 6;
    const int gw = blockIdx.x * NWAVES + wave, NGW = gridDim.x * NWAVES;
    const bf16_t* H = (const bf16_t*)(p.ws + WS_XA); const bf16_t* O = (const bf16_t*)(p.ws + WS_O); bf16_t* HG = (bf16_t*)(p.ws + WS_QK);
    const float* nw = p.in[I_ANW];
    for (int tok = gw; tok < TOK; tok += NGW) {
#pragma unroll 2
        for (int h = 0; h < 8; ++h) { const size_t off = (size_t)tok * 2048 + h * 256 + lane * 4;
            const u32x2 hw = *(const u32x2*)(H + off), ow = *(const u32x2*)(O + off);
            const float h0 = bf_lo(hw.x), h1 = bf_hi(hw.x), h2 = bf_lo(hw.y), h3 = bf_hi(hw.y);
            const float mu = wave_sum((h0 + h1) + (h2 + h3)) * (1.0f / 256.0f);
            const float d0 = h0 - mu, d1 = h1 - mu, d2 = h2 - mu, d3 = h3 - mu;
            const float var = wave_sum((d0 * d0 + d1 * d1) + (d2 * d2 + d3 * d3)) * (1.0f / 256.0f);
            const float rstd = 1.0f / sqrtf(var + 1e-5f);
            const f32x4 g = *(const f32x4*)(nw + h * 256 + lane * 4);
            const float o0 = bf_lo(ow.x), o1 = bf_hi(ow.x), o2 = bf_lo(ow.y), o3 = bf_hi(ow.y);
            u32x2 r; r.x = cvt_pk_bf16(d0 * rstd * g[0] / (1.0f + __expf(-o0)), d1 * rstd * g[1] / (1.0f + __expf(-o1)));
            r.y = cvt_pk_bf16(d2 * rstd * g[2] / (1.0f + __expf(-o2)), d3 * rstd * g[3] / (1.0f + __expf(-o3)));
            *(u32x2*)(HG + off) = r; }
    }
}
template <bool OUTF32> __device__ __forceinline__ void ln_phase(const float* Y, const float* g, const float* bta, void* out) {
    int tid_ = threadIdx.x; asm volatile("" : "+v"(tid_)); const int tid = tid_, lane = tid & 63, wave = tid >> 6;
    const int gw = blockIdx.x * NWAVES + wave, NGW = gridDim.x * NWAVES;
    for (int row = gw; row < TOK; row += NGW) {
        const f32x4* yr = (const f32x4*)(Y + (size_t)row * 2048) + lane;
        f32x4 v[8]; float s = 0.f;
#pragma unroll
        for (int j = 0; j < 8; ++j) { v[j] = yr[64 * j]; s += (v[j][0] + v[j][1]) + (v[j][2] + v[j][3]); }
        const float mean = wave_sum(s) * (1.0f / 2048.0f); float s2 = 0.f;
#pragma unroll
        for (int j = 0; j < 8; ++j) { v[j] = v[j] - mean; s2 += (v[j][0] * v[j][0] + v[j][1] * v[j][1]) + (v[j][2] * v[j][2] + v[j][3] * v[j][3]); }
        const float rstd = 1.0f / sqrtf(wave_sum(s2) * (1.0f / 2048.0f) + 1e-5f);
#pragma unroll
        for (int j = 0; j < 8; ++j) { const int col = (lane + 64 * j) * 4; const f32x4 gg = *(const f32x4*)(g + col), bb = *(const f32x4*)(bta + col);
            const f32x4 o = v[j] * rstd * gg + bb;
            if (OUTF32) *(f32x4*)((float*)out + (size_t)row * 2048 + col) = o;
            else { u32x2 r; r.x = cvt_pk_bf16(o[0], o[1]); r.y = cvt_pk_bf16(o[2], o[3]); *(u32x2*)((bf16_t*)out + (size_t)row * 2048 + col) = r; } }
    }
}
__device__ __forceinline__ void ln_final_phase(const bf16_t* Y, const float* st, const float* g, const float* bta, float* out) {
    int tid_ = threadIdx.x; asm volatile("" : "+v"(tid_)); const int tid = tid_, lane = tid & 63, wave = tid >> 6;
    const int gw = blockIdx.x * NWAVES + wave, NGW = gridDim.x * NWAVES;
    for (int row = gw; row < TOK; row += NGW) {
        float mu, rstd; pg8::ln_row(st, row, mu, rstd);
#pragma unroll
        for (int j = 0; j < 4; ++j) { const int col = (lane + 64 * j) * 8; const u32x4 w = *(const u32x4*)(Y + (size_t)row * 2048 + col);
            const f32x4 y0 = {bf_lo(w.x), bf_hi(w.x), bf_lo(w.y), bf_hi(w.y)}, y1 = {bf_lo(w.z), bf_hi(w.z), bf_lo(w.w), bf_hi(w.w)};
            const f32x4 g0 = *(const f32x4*)(g + col), g1 = *(const f32x4*)(g + col + 4), b0 = *(const f32x4*)(bta + col), b1 = *(const f32x4*)(bta + col + 4);
            *(f32x4*)(out + (size_t)row * 2048 + col) = (y0 - mu) * rstd * g0 + b0; *(f32x4*)(out + (size_t)row * 2048 + col + 4) = (y1 - mu) * rstd * g1 + b1; }
    }
}
typedef short v4i16_t __attribute__((ext_vector_type(4)));
__device__ __forceinline__ s16x4 lds_tr(const bf16_t* ptr) { return __builtin_bit_cast(s16x4, __builtin_amdgcn_ds_read_tr16_b64_v4i16((LAS v4i16_t*)ptr)); }
constexpr int AT_KS = 200, AT_VS = 144, AT_KB = 64 * AT_KS, AT_VB = 64 * AT_VS;
__device__ __forceinline__ void attn_phase(const Params& p, unsigned char* lds) {
    int tid_ = threadIdx.x; asm volatile("" : "+v"(tid_)); const int tid = tid_, lane = tid & 63, w = tid >> 6, fr = lane & 15, fq = lane >> 4;
    bf16_t* LK = (bf16_t*)lds;
    bf16_t* LV = LK + 2 * AT_KB;
    const bf16_t* Q = (const bf16_t*)p.out; const bf16_t* KN = (const bf16_t*)(p.ws + WS_KN); const bf16_t* VV = (const bf16_t*)(p.ws + WS_VV); const bf16_t* KR = (const bf16_t*)(p.ws + WS_KR);
    bf16_t* AO = (bf16_t*)(p.ws + WS_AO);
    const int key0 = tid >> 4, cg0 = tid & 15, keyr = tid >> 3, cgr = tid & 7;
    const bool late = (w >= 4);
    { const int wg = blockIdx.x;
        const int bh = wg >> 1, par = wg & 1, b = bh >> 4, h = bh & 15;
        const bf16_t* KNb = KN + ((size_t)bh * 2048 + key0) * 128 + cg0 * 8;
        const bf16_t* VVb = VV + ((size_t)bh * 2048 + key0) * 128 + cg0 * 8;
        const bf16_t* KRb = KR + (size_t)b * SEQ * 64 + (size_t)keyr * 64 + cgr * 8;
        for (int ui = 0; ui < 4; ++ui) {
            const int j = par * 2 + (ui >> 1), qb = (ui & 1) ? 7 - j : j;
            const size_t row0 = (size_t)b * SEQ + qb * 256 + 32 * w;
            bf16x8 qf[2][6];
#pragma unroll
            for (int qi = 0; qi < 2; ++qi)
#pragma unroll
                for (int ks = 0; ks < 6; ++ks) qf[qi][ks] = *(const bf16x8*)(Q + (row0 + 16 * qi + fr) * 3072 + h * 192 + 32 * ks + 8 * fq);
            f32x4 oacc[2][8];
#pragma unroll
            for (int qi = 0; qi < 2; ++qi)
#pragma unroll
                for (int i = 0; i < 8; ++i) oacc[qi][i] = (f32x4){0.f, 0.f, 0.f, 0.f};
            float mrow[2] = {-1e30f, -1e30f}, lsum[2] = {0.f, 0.f};
            f32x4 sacc[2][4];
            const int ntile = 4 * qb + 4, mylast = 4 * qb + (w >> 1);
            u32x4 pk0, pk1, pkr, pv0, pv1;
#define AT_LOAD(t) do { const size_t o_ = (size_t)(t) * 64 * 128; pk0 = *(const u32x4*)(KNb + o_); pk1 = *(const u32x4*)(KNb + o_ + 32 * 128); pkr = *(const u32x4*)(KRb + (size_t)(t) * 64 * 64); \
                pv0 = *(const u32x4*)(VVb + o_); pv1 = *(const u32x4*)(VVb + o_ + 32 * 128); } while (0)
#define AT_STORE(kbi, vbi) do { bf16_t* Kd = LK + (kbi) * AT_KB; bf16_t* Vd = LV + (vbi) * AT_VB; *(u32x4*)(Kd + key0 * AT_KS + cg0 * 8) = pk0; *(u32x4*)(Kd + (key0 + 32) * AT_KS + cg0 * 8) = pk1; \
                *(u32x4*)(Kd + keyr * AT_KS + 128 + cgr * 8) = pkr; *(u32x4*)(Vd + key0 * AT_VS + cg0 * 8) = pv0; *(u32x4*)(Vd + (key0 + 32) * AT_VS + cg0 * 8) = pv1; } while (0)
#define AT_S(kbi) do { const bf16_t* Kt = LK + (kbi) * AT_KB; \
                _Pragma("unroll") for (int kt = 0; kt < 4; ++kt) { sacc[0][kt] = (f32x4){0.f, 0.f, 0.f, 0.f}; sacc[1][kt] = (f32x4){0.f, 0.f, 0.f, 0.f}; \
                    _Pragma("unroll") for (int ks = 0; ks < 6; ++ks) { const bf16x8 A = *(const bf16x8*)(Kt + (16 * kt + fr) * AT_KS + 32 * ks + 8 * fq); \
                        sacc[0][kt] = MFMA16(A, qf[0][ks], sacc[0][kt]); sacc[1][kt] = MFMA16(A, qf[1][ks], sacc[1][kt]); } asm volatile("" ::: "memory"); } } while (0)
#define AT_PV(vbi) do { const bf16_t* Vt = LV + (vbi) * AT_VB; bf16x8 pf[2][2]; \
                _Pragma("unroll") for (int qi = 0; qi < 2; ++qi) { float mx = -1e30f; \
                    _Pragma("unroll") for (int kt = 0; kt < 4; ++kt) mx = fmaxf(mx, fmaxf(fmaxf(sacc[qi][kt][0], sacc[qi][kt][1]), fmaxf(sacc[qi][kt][2], sacc[qi][kt][3]))); \
                    mx = fmaxf(mx, __shfl_xor(mx, 16)); mx = fmaxf(mx, __shfl_xor(mx, 32)); \
                    if (__any(mx > mrow[qi] + 8.0f)) {     \
                        const float mnew = fmaxf(mrow[qi], mx), alpha = __builtin_amdgcn_exp2f(mrow[qi] - mnew); mrow[qi] = mnew; lsum[qi] *= alpha; \
                        _Pragma("unroll") for (int vt = 0; vt < 8; ++vt) oacc[qi][vt] = oacc[qi][vt] * alpha; } \
                    const float mref = mrow[qi]; float ps = 0.f; \
                    _Pragma("unroll") for (int kt = 0; kt < 4; ++kt) _Pragma("unroll") for (int i = 0; i < 4; ++i) { const float e = __builtin_amdgcn_exp2f(sacc[qi][kt][i] - mref); sacc[qi][kt][i] = e; ps += e; } \
                    lsum[qi] += ps; \
                    pf[qi][0] = __builtin_bit_cast(bf16x8, pg8::pack8(sacc[qi][0], sacc[qi][1])); pf[qi][1] = __builtin_bit_cast(bf16x8, pg8::pack8(sacc[qi][2], sacc[qi][3])); } \
                const bf16_t* vb = Vt + (4 * fq + (fr >> 2)) * AT_VS + 4 * (fr & 3); \
                _Pragma("unroll") for (int vt = 0; vt < 8; ++vt) _Pragma("unroll") for (int k2 = 0; k2 < 2; ++k2) { const s16x4 lo = lds_tr(vb + (32 * k2) * AT_VS + 16 * vt), hi = lds_tr(vb + (32 * k2 + 16) * AT_VS + 16 * vt); \
                    const bf16x8 A = {lo[0], lo[1], lo[2], lo[3], hi[0], hi[1], hi[2], hi[3]}; \
                    oacc[0][vt] = MFMA16(A, pf[0][k2], oacc[0][vt]); oacc[1][vt] = MFMA16(A, pf[1][k2], oacc[1][vt]); if (k2 == 1) asm volatile("" ::: "memory"); } } while (0)
            AT_LOAD(0);
            __syncthreads();
            AT_STORE(0, 0);
            __builtin_amdgcn_s_waitcnt(0x0F70);
            __syncthreads();
            int vs = 0;
            for (int t = 0; t < ntile; ++t) {
                const int vnext = (vs == 2) ? 0 : vs + 1, vprev = (vs == 0) ? 2 : vs - 1;
                if (t + 1 < ntile) AT_LOAD(t + 1);
                if (late && t >= 1 && t - 1 <= mylast) AT_PV(vprev);
                if (t <= mylast) { AT_S(t & 1); if (!late) AT_PV(vs); }
                if (t + 1 < ntile) AT_STORE((t + 1) & 1, vnext);
                __syncthreads();
                vs = vnext;
            }
            if (late && ntile - 1 <= mylast) { const int vlast = (vs == 0) ? 2 : vs - 1; AT_PV(vlast); }
#undef AT_LOAD
#undef AT_STORE
#undef AT_S
#undef AT_PV
#pragma unroll
            for (int qi = 0; qi < 2; ++qi) { float l = lsum[qi]; l += __shfl_xor(l, 16); l += __shfl_xor(l, 32);
                const float inv = 1.0f / l;
#pragma unroll
                for (int vt = 0; vt < 8; ++vt) { u32x2 r; r.x = cvt_pk_bf16(oacc[qi][vt][0] * inv, oacc[qi][vt][1] * inv); r.y = cvt_pk_bf16(oacc[qi][vt][2] * inv, oacc[qi][vt][3] * inv);
                    *(u32x2*)(AO + (row0 + 16 * qi + fr) * 2048 + h * 128 + 16 * vt + 4 * fq) = r; } }
        }
    }
}
__device__ __forceinline__ void krope_phase(const Params& p) {
    int tid_ = threadIdx.x; asm volatile("" : "+v"(tid_)); const int tid = tid_, lane = tid & 63, w = tid >> 6, fr = lane & 15, fq = lane >> 4;
    const bf16_t* XA = (const bf16_t*)(p.ws + WS_XA); const bf16_t* WR = (const bf16_t*)(p.ws + WS_W_DN) + (size_t)1024 * 2048;
    const float* ST2 = (const float*)(p.ws + WS_LNST) + 2 * TOK; const float* UC = (const float*)(p.ws + WS_UC); const float* rope = (const float*)(p.ws + WS_ROPE);
    bf16_t* KR = (bf16_t*)(p.ws + WS_KR);
    const int tok0 = blockIdx.x * 64 + (w & 3) * 16, c0 = (w >> 2) * 32;
    const bf16_t* ap = XA + (size_t)(tok0 + fr) * 2048 + 8 * fq;
    const bf16_t* bp0 = WR + (size_t)(c0 + fr) * 2048 + 8 * fq; const bf16_t* bp1 = bp0 + (size_t)16 * 2048;
    f32x4 a0 = {0.f, 0.f, 0.f, 0.f}, a1 = {0.f, 0.f, 0.f, 0.f};
#pragma unroll 8
    for (int ks = 0; ks < 64; ++ks) { const bf16x8 A = *(const bf16x8*)(ap + 32 * ks); a0 = MFMA16(A, *(const bf16x8*)(bp0 + 32 * ks), a0); a1 = MFMA16(A, *(const bf16x8*)(bp1 + 32 * ks), a1); }
#pragma unroll
    for (int nt = 0; nt < 2; ++nt) { const int col = c0 + 16 * nt + fr; const float uu = UC[UC_U2 + 1024 + col], cc = UC[UC_C2 + 1024 + col];
#pragma unroll
        for (int i = 0; i < 4; ++i) { const int row = tok0 + 4 * fq + i; float mu, rstd; pg8::ln_row(ST2, row, mu, rstd);
            const float v = ((nt ? a1[i] : a0[i]) - mu * uu) * rstd + cc; const float o = __shfl_xor(v, 1);
            const float cs = rope[((size_t)(row & 2047) * 32 + (col >> 1)) * 2], sn = rope[((size_t)(row & 2047) * 32 + (col >> 1)) * 2 + 1];
            const float r = (col & 1) ? (v * cs + o * sn) : (v * cs - o * sn);
            KR[(size_t)row * 64 + col] = (bf16_t)f2bf(r); } }
}
#define XB_TMO      128
#define XB_XCNT(j)  (256  + 64 * (j))
#define XB_XSUB(j)  (1280 + 64 * (j))
#define XB_XGEN(j)  (2304 + 64 * (j))
#define XB_TOP      3328
#define XB_TOPGEN   3392
#define XCD_BAR_WORDS 3456
#define XB_SPIN_CAP (1u << 18)

__device__ __forceinline__ unsigned xb_ld(unsigned* p)              { return __hip_atomic_load(p, __ATOMIC_RELAXED, __HIP_MEMORY_SCOPE_AGENT); }
__device__ __forceinline__ unsigned xb_add(unsigned* p, unsigned v) { return __hip_atomic_fetch_add(p, v, __ATOMIC_RELAXED, __HIP_MEMORY_SCOPE_AGENT); }
__device__ __forceinline__ unsigned xb_xcc_id() { return (unsigned)__builtin_amdgcn_s_getreg((3 << 11) | 20) & 0xFu; }
#define XB_SPIN(cond, bar) do { unsigned _sp = 0; while (cond) { __builtin_amdgcn_s_sleep(1); \
    if ((++_sp & 255u) == 0u) { if (xb_ld(&(bar)[XB_TMO])) break; if (_sp > XB_SPIN_CAP) { atomicAdd(&(bar)[XB_TMO], 1u); break; } } } } while (0)

struct XcdBarrier {
    unsigned* bar; unsigned x;
    volatile LAS unsigned* st;
};

__device__ __forceinline__ XcdBarrier xcd_barrier_post(unsigned* bar, volatile LAS unsigned* st) {
    XcdBarrier b; b.bar = bar; b.x = xb_xcc_id(); b.st = st;
    if (threadIdx.x == 0) (void)xb_add(&bar[XB_XCNT(b.x)], 1u);
    return b;
}
__device__ __forceinline__ void xcd_barrier_complete(unsigned* bar, unsigned x, unsigned& nloc, unsigned& nx) {
    const unsigned G = gridDim.x * gridDim.y * gridDim.z;
    unsigned sum, cnt, mine, sp = 0u;
    for (;;) {
        sum = 0u; cnt = 0u; mine = 0u;
#pragma unroll
        for (unsigned j = 0; j < 16; ++j) { const unsigned c = xb_ld(&bar[XB_XCNT(j)]); sum += c; cnt += (c > 0u) ? 1u : 0u; mine = (j == x) ? c : mine; }
        if (sum == G) break;
        __builtin_amdgcn_s_sleep(1);
        if ((++sp & 255u) == 0u) { if (xb_ld(&bar[XB_TMO])) break; if (sp > XB_SPIN_CAP) { atomicAdd(&bar[XB_TMO], 1u); break; } }
    }
    nloc = mine > 0u ? mine : 1u; nx = cnt > 0u ? cnt : 1u;
}

__device__ __forceinline__ void xcd_barrier(const XcdBarrier& b) {
    asm volatile("s_waitcnt vmcnt(0)" ::: "memory");
    __syncthreads();
    if (threadIdx.x == 0) {
        unsigned* bar = b.bar;
        __builtin_amdgcn_s_waitcnt(0);
        unsigned nloc = b.st[0], nx = b.st[1];
        if (nloc == 0u) { xcd_barrier_complete(bar, b.x, nloc, nx); b.st[0] = nloc; b.st[1] = nx; }
        const unsigned old = xb_add(&bar[XB_XSUB(b.x)], 1u);
        const unsigned gen = old / nloc;
        if (old + 1u == (gen + 1u) * nloc) {
            __builtin_amdgcn_fence(__ATOMIC_RELEASE, "agent");
            asm volatile("s_waitcnt vmcnt(0)" ::: "memory");
            const unsigned og = xb_add(&bar[XB_TOP], 1u);
            const unsigned tg = og / nx;
            if (og + 1u == (tg + 1u) * nx) xb_add(&bar[XB_TOPGEN], 1u);
            else XB_SPIN(xb_ld(&bar[XB_TOPGEN]) == tg, bar);
            __builtin_amdgcn_fence(__ATOMIC_ACQUIRE, "agent");
            xb_add(&bar[XB_XGEN(b.x)], 1u);
            asm volatile("s_waitcnt vmcnt(0)" ::: "memory");
        } else {
            XB_SPIN(xb_ld(&bar[XB_XGEN(b.x)]) == gen, bar);
            __builtin_amdgcn_fence(__ATOMIC_ACQUIRE, "agent");
            asm volatile("s_waitcnt vmcnt(0)" ::: "memory");
        }
    }
    __syncthreads();
}

#ifndef REP_ATTN
#define REP_ATTN 1
#endif
#ifndef REP_MLSTM
#define REP_MLSTM 1
#endif
#ifndef REP_P0
#define REP_P0 1
#endif
__device__ __forceinline__ int opq(int v) { asm volatile("" : "+s"(v)); return v; }
#define GSYNC() xcd_barrier(xbar)
template <int LAYER> __device__ __forceinline__ void layer_body(const Params& p, unsigned char* lds, const XcdBarrier& xbar) {
    LAS unsigned char* ldsl = (LAS unsigned char*)lds;
    unsigned char* ws = p.ws;
    const int G = (int)gridDim.x, bx = (int)blockIdx.x;
    bf16_t* XA = (bf16_t*)(ws + WS_XA); bf16_t* HID = (bf16_t*)(ws + WS_BIG);
    float* ST1 = (float*)(ws + WS_LNST), *ST2 = ST1 + 2 * TOK, *ST3 = ST2 + 2 * TOK;
    const float* UC = (const float*)(ws + WS_UC);
    if (LAYER == 1) {
        krope_phase(p);
        { pg8::Gemm g{XA, (const bf16_t*)(ws + WS_W_DN), TOK, 1024, opq(2048)}; pg8::StaticOrder S; S.init(TOK, 1024, G, bx, WGM_DN);
          pg8::EpiDown E{(bf16_t*)(ws + WS_C), (bf16_t*)(ws + WS_QL), (bf16_t*)(ws + WS_KR), (float*)(ws + WS_RMS), (const float*)(ws + WS_ROPE), ST2, UC + UC_U2, UC + UC_C2};
          pg8::gemm_phase<pg8::EpiDown, pg8::StaticOrder, true, true>(ldsl, g, S, E); }
        GSYNC();
        { pg8::Gemm g{(const bf16_t*)(ws + WS_C), (const bf16_t*)(ws + WS_W_KVUP), TOK, 4096, opq(512)}; pg8::StaticOrder S; S.init(TOK, 4096, G, bx, WGM_KV);
          pg8::EpiKvUp E{(bf16_t*)(ws + WS_KN), (bf16_t*)(ws + WS_VV), (const float*)(ws + WS_RMS)};
          pg8::gemm_phase<pg8::EpiKvUp, pg8::StaticOrder, true, true>(ldsl, g, S, E); }
        { pg8::Gemm g{(const bf16_t*)(ws + WS_QL), (const bf16_t*)(ws + WS_W_QUP), TOK, 3072, opq(512)}; pg8::StaticOrder S; S.init(TOK, 3072, G, bx, WGM_Q);
          pg8::EpiQUp E{(bf16_t*)p.out, (const float*)(ws + WS_RMS), (const float*)(ws + WS_ROPE), 0.10411754627697264f};
          pg8::gemm_phase<pg8::EpiQUp, pg8::StaticOrder, true, true>(ldsl, g, S, E); }
        GSYNC();
        attn_phase(p, lds);
#if REP_ATTN > 1
        attn_phase(p, lds);
#endif
        GSYNC();
    }
    if (LAYER == 0) {
        pg8::Gemm g{(const bf16_t*)(ws + WS_QK), (const bf16_t*)(ws + WS_W_AOUT), TOK, 2048, opq(2048)}; pg8::StaticOrder S; S.init(TOK, 2048, G, bx, WGM_N2K);
        pg8::EpiFirst E{p.in[I_X], XA, ST1, DN_ALPHA};
        pg8::gemm_phase<pg8::EpiFirst, pg8::StaticOrder, true, true>(ldsl, g, S, E);
    } else {
        pg8::Gemm g{(const bf16_t*)(ws + WS_AO), (const bf16_t*)(ws + WS_W_BOUT), TOK, 2048, opq(2048)}; pg8::StaticOrder S; S.init(TOK, 2048, G, bx, WGM_N2K);
        pg8::EpiResLn<false> E{XA, ST2, p.in[I_L2G], p.in[I_L2B], ST3, nullptr, DN_ALPHA};
        pg8::gemm_phase<pg8::EpiResLn<false>, pg8::StaticOrder, true, true>(ldsl, g, S, E);
    }
    GSYNC();
    { pg8::Gemm g{XA, (const bf16_t*)(ws + (LAYER ? WS_W1_1 : WS_W1_0)), TOK, DFF, opq(2048)}; pg8::StaticOrder S; S.init(TOK, DFF, G, bx, WGM_UP);
      pg8::EpiUpLn E{HID, DFF, LAYER ? ST3 : ST1, UC + (LAYER ? UC_U3 : UC_U1), UC + (LAYER ? UC_C3 : UC_C1)};
      pg8::gemm_phase<pg8::EpiUpLn, pg8::StaticOrder, true, true>(ldsl, g, S, E); }
    GSYNC();
    if (LAYER == 0) {
        pg8::Gemm g{HID, (const bf16_t*)(ws + WS_W2_0), TOK, 2048, opq(DFF)}; pg8::StaticOrder S; S.init(TOK, 2048, G, bx, WGM_N2K);
        pg8::EpiResLn<false> E{XA, ST1, p.in[I_L1G], p.in[I_L1B], ST2, nullptr, DN_ALPHA};
        pg8::gemm_phase<pg8::EpiResLn<false>, pg8::StaticOrder, true, true>(ldsl, g, S, E);
        GSYNC();
    } else {
        pg8::Gemm g{HID, (const bf16_t*)(ws + WS_W2_1), TOK, 2048, opq(DFF)}; pg8::StaticOrder S; S.init(TOK, 2048, G, bx, WGM_N2K);
        pg8::EpiResLn<false> E{XA, ST3, p.in[I_L1G] + 2048, p.in[I_L1B] + 2048, ST3 + 2 * TOK, nullptr, DN_ALPHA};
        pg8::gemm_phase<pg8::EpiResLn<false>, pg8::StaticOrder, true, true>(ldsl, g, S, E);
        GSYNC();
        ln_final_phase(XA, ST3 + 2 * TOK, p.in[I_L2G] + 2048, p.in[I_L2B] + 2048, p.out);
    }
}
__global__ void __launch_bounds__(NTHR, 2) yoco_fwd(Params p) {
    extern __shared__ __attribute__((aligned(16))) unsigned char lds[];
    cg::grid_group grid = cg::this_grid();
    unsigned* barw = (unsigned*)(p.ws + WS_BAR);
    volatile LAS unsigned* stw = (volatile LAS unsigned*)((LAS unsigned char*)lds + LDS_MISC);
    if (threadIdx.x < 2) stw[threadIdx.x] = 0u;
    __syncthreads();
    const XcdBarrier xbar = xcd_barrier_post(barw, stw);
    if (p.ws == nullptr) grid.sync();
    p0_prologue(p, lds);
#if REP_P0 > 1
    p0_prologue(p, lds);
#endif
    GSYNC();
    { pg8::Gemm g{(const bf16_t*)(p.ws + WS_XB), (const bf16_t*)(p.ws + WS_W_IN), TOK, 6144, opq(2048)}; pg8::StaticOrder S; S.init(TOK, 6144, (int)gridDim.x, (int)blockIdx.x, WGM_P1);
      pg8::EpiSplitBf16<0> E{(bf16_t*)(p.ws + WS_QK), 2048, 8, (size_t)(64 * MiB / 2), 1};
      pg8::gemm_phase<pg8::EpiSplitBf16<0>, pg8::StaticOrder, true, true>((LAS unsigned char*)lds, g, S, E); }
    GSYNC();
    conv_phase(p);
    GSYNC();
    mlstm_phase(p, lds);
#if REP_MLSTM > 1
    mlstm_phase(p, lds);
#endif
    GSYNC();
#ifndef SKIP_GATE
    gate_phase(p);
#endif
    GSYNC();
    layer_body<0>(p, lds, xbar);
    layer_body<1>(p, lds, xbar);
}

extern "C" void kernel_launch(void* const* d_in, const int* in_sizes, int n_in, void* d_out, int out_size, void* d_ws, size_t ws_size, hipStream_t stream) {
    static int grid = 0;
    if (grid == 0) {
        if (n_in != 20 || out_size != TOK * DM || ws_size < WS_END) { fprintf(stderr, "kernel_launch: unexpected shapes: n_in %d out %d ws %zu (need %zu)\n", n_in, out_size, ws_size, (size_t)WS_END); grid = -1; return; }
        int dev = 0, cus = 0, per_cu = 0;
        hipGetDevice(&dev); hipDeviceGetAttribute(&cus, hipDeviceAttributeMultiprocessorCount, dev);
        if (hipFuncSetAttribute((const void*)yoco_fwd, hipFuncAttributeMaxDynamicSharedMemorySize, LDS_BYTES) != hipSuccess) { fprintf(stderr, "kernel_launch: hipFuncSetAttribute failed\n"); grid = -1; return; }
        if (hipOccupancyMaxActiveBlocksPerMultiprocessor(&per_cu, (const void*)yoco_fwd, NTHR, LDS_BYTES) != hipSuccess || per_cu < 1) { fprintf(stderr, "kernel_launch: occupancy query gave %d\n", per_cu); per_cu = 1; }
        (void)hipGetLastError();
        grid = cus * per_cu;
        if (grid > 256) grid = 256;
        if (grid != 256) { fprintf(stderr, "kernel_launch: this kernel needs exactly 256 resident workgroups, got %d\n", grid); grid = -1; return; }
    }
    if (grid < 0) return;
    if (hipMemsetAsync((char*)d_ws + WS_CTL2, 0, MiB, stream) != hipSuccess) { fprintf(stderr, "kernel_launch: memset failed\n"); return; }
    Params p{};
    for (int i = 0; i < 20; ++i) p.in[i] = (const float*)d_in[i];
    p.out = (float*)d_out; p.ws = (unsigned char*)d_ws;
    void* args[] = {&p};
    hipError_t e = hipLaunchCooperativeKernel((const void*)yoco_fwd, dim3(grid), dim3(NTHR), args, LDS_BYTES, stream);
    if (e != hipSuccess) fprintf(stderr, "cooperative launch failed: %s (grid %d)\n", hipGetErrorString(e), grid);
}
```
